# Optimizing an MI355X kernel written in HIP

```python
import math
import jax
import jax.numpy as jnp
from jax import lax
import numpy as np

D_MODEL = 1024
BATCH = 4
SEQ = 4096
DEPTH = 2

N_MIXERS = 2
N_SSM_LAYERS = (DEPTH + N_MIXERS - 1) // N_MIXERS
N_ATTN_LAYERS = DEPTH // N_MIXERS

SSM_WIDTH = D_MODEL
SSM_GROUP = 16
SSM_GROUPS = SSM_WIDTH // SSM_GROUP
SSM_STATE = 64
DT_MIN = 1e-3
DT_MAX = 1e-1

ATT_HEADS = 8
HEAD_DIM = D_MODEL // ATT_HEADS
MOBA_BLOCK = 256
MOBA_TOPK = 3
Q_CHUNK = 32

N_GROUPS = 4
EXPERTS_PER_GROUP = 8
N_EXPERTS = N_GROUPS * EXPERTS_PER_GROUP
EXPERT_TOPK = 2
EXPERT_FF = D_MODEL // 2
ROW_BLOCK = 128

RMS_EPS = 1e-6
NEG_INF = -1e30

kernel_name = 'hybrid_s5_moba_hmoe'


def rmsnorm(x, g):
    xf = x.astype(jnp.float32)
    y = xf * lax.rsqrt(jnp.mean(xf * xf, axis=-1, keepdims=True) + RMS_EPS)
    return (y * g.astype(jnp.float32)).astype(x.dtype)


def _ssm_combine(left, right):
    a1r, a1i, b1r, b1i = left
    a2r, a2i, b2r, b2i = right
    return (a2r * a1r - a2i * a1i,
            a2r * a1i + a2i * a1r,
            a2r * b1r - a2i * b1i + b2r,
            a2r * b1i + a2i * b1r + b2i)


def s5_mixer(h, w_in, lam_re, lam_im, log_dt, b_re, b_im, c_re, c_im, d_skip, w_out):
    f32 = jnp.float32
    bsz, s, _ = h.shape
    u = (h @ w_in).astype(f32)
    ug = u.reshape(bsz, s, SSM_GROUPS, SSM_GROUP)
    lr = jnp.minimum(lam_re.astype(f32), -1e-4)
    li = lam_im.astype(f32)
    dt = jnp.exp(log_dt.astype(f32))[:, None]
    mag = jnp.exp(lr * dt)
    abar_re = mag * jnp.cos(li * dt)
    abar_im = mag * jnp.sin(li * dt)
    den = lr * lr + li * li
    nr = abar_re - 1.0
    gam_re = (nr * lr + abar_im * li) / den
    gam_im = (abar_im * lr - nr * li) / den
    br = b_re.astype(f32)
    bi = b_im.astype(f32)
    bb_re = gam_re[..., None] * br - gam_im[..., None] * bi
    bb_im = gam_re[..., None] * bi + gam_im[..., None] * br
    bu_re = jnp.einsum('bsgc,gpc->bsgp', ug, bb_re)
    bu_im = jnp.einsum('bsgc,gpc->bsgp', ug, bb_im)
    a_re = jnp.broadcast_to(abar_re, (1, s, SSM_GROUPS, SSM_STATE))
    a_im = jnp.broadcast_to(abar_im, (1, s, SSM_GROUPS, SSM_STATE))
    _, _, xr, xi = lax.associative_scan(_ssm_combine, (a_re, a_im, bu_re, bu_im), axis=1)
    y = (jnp.einsum('bsgp,gcp->bsgc', xr, c_re.astype(f32))
         - jnp.einsum('bsgp,gcp->bsgc', xi, c_im.astype(f32)))
    y = y.reshape(bsz, s, SSM_WIDTH) + d_skip.astype(f32) * u
    z = jax.nn.gelu(y).astype(h.dtype)
    vg = z @ w_out
    v, g = jnp.split(vg, 2, axis=-1)
    return v * jax.nn.sigmoid(g)


def moba_mixer(h, w_qkv, w_o):
    f32 = jnp.float32
    bsz, s, _ = h.shape
    qkv = (h @ w_qkv).reshape(bsz, s, 3, ATT_HEADS, HEAD_DIM)
    q = qkv[:, :, 0].transpose(0, 2, 1, 3)
    k = qkv[:, :, 1].transpose(0, 2, 1, 3)
    v = qkv[:, :, 2].transpose(0, 2, 1, 3)
    nb = -(-s // MOBA_BLOCK)
    pad = nb * MOBA_BLOCK - s
    kb = jnp.pad(k, ((0, 0), (0, 0), (0, pad), (0, 0))).reshape(bsz, ATT_HEADS, nb, MOBA_BLOCK, HEAD_DIM)
    vb = jnp.pad(v, ((0, 0), (0, 0), (0, pad), (0, 0))).reshape(bsz, ATT_HEADS, nb, MOBA_BLOCK, HEAD_DIM)
    kmean = jnp.mean(kb.astype(f32), axis=3)
    gate = jnp.einsum('bhsd,bhnd->bhsn', q.astype(f32), kmean)
    cur = jnp.arange(s) // MOBA_BLOCK
    past = jnp.arange(nb)[None, :] < cur[:, None]
    gate = jnp.where(past, gate, NEG_INF)
    k_sel = min(MOBA_TOPK, nb)
    _, idx = lax.top_k(gate, k_sel)
    sel_valid = idx < cur[None, None, :, None]
    scale = HEAD_DIM ** -0.5
    b_ix = jnp.arange(bsz)[:, None, None, None]
    h_ix = jnp.arange(ATT_HEADS)[None, :, None, None]

    def chunk(c):
        q0 = c * Q_CHUNK
        qc = lax.dynamic_slice_in_dim(q, q0, Q_CHUNK, axis=2)
        ic = lax.dynamic_slice_in_dim(idx, q0, Q_CHUNK, axis=2)
        vc = lax.dynamic_slice_in_dim(sel_valid, q0, Q_CHUNK, axis=2)
        k_g = kb[b_ix, h_ix, ic]
        v_g = vb[b_ix, h_ix, ic]
        s_sel = jnp.einsum('bhqd,bhqkld->bhqkl', qc, k_g).astype(f32) * scale
        s_sel = jnp.where(vc[..., None], s_sel, NEG_INF).reshape(bsz, ATT_HEADS, Q_CHUNK, k_sel * MOBA_BLOCK)
        own = q0 // MOBA_BLOCK
        k_own = lax.dynamic_index_in_dim(kb, own, axis=2, keepdims=False)
        v_own = lax.dynamic_index_in_dim(vb, own, axis=2, keepdims=False)
        s_own = jnp.einsum('bhqd,bhld->bhql', qc, k_own).astype(f32) * scale
        qpos = q0 + jnp.arange(Q_CHUNK)
        kpos = own * MOBA_BLOCK + jnp.arange(MOBA_BLOCK)
        s_own = jnp.where(kpos[None, :] <= qpos[:, None], s_own, NEG_INF)
        p = jax.nn.softmax(jnp.concatenate([s_sel, s_own], axis=-1), axis=-1)
        p_sel = p[..., :k_sel * MOBA_BLOCK].reshape(bsz, ATT_HEADS, Q_CHUNK, k_sel, MOBA_BLOCK).astype(v.dtype)
        p_own = p[..., k_sel * MOBA_BLOCK:].astype(v.dtype)
        return (jnp.einsum('bhqkl,bhqkld->bhqd', p_sel, v_g)
                + jnp.einsum('bhql,bhld->bhqd', p_own, v_own))

    o = lax.map(chunk, jnp.arange(s // Q_CHUNK))
    o = o.transpose(1, 0, 3, 2, 4).reshape(bsz, s, ATT_HEADS * HEAD_DIM)
    return o @ w_o


def hier_moe(h, w_group, w_expert, w1, w3, w2):
    f32 = jnp.float32
    bsz, s, d = h.shape
    n = bsz * s
    xt = h.reshape(n, d)
    g_prob = jax.nn.softmax((xt @ w_group).astype(f32), axis=-1)
    g_gate, g_idx = lax.top_k(g_prob, 1)
    e_logits = (xt @ w_expert).astype(f32).reshape(n, N_GROUPS, EXPERTS_PER_GROUP)
    e_in = e_logits[jnp.arange(n), g_idx[:, 0]]
    e_gate, e_local = lax.top_k(jax.nn.softmax(e_in, axis=-1), EXPERT_TOPK)
    e_gate = e_gate / jnp.sum(e_gate, axis=-1, keepdims=True)
    gates = (g_gate * e_gate).reshape(-1)
    expert_id = (g_idx * EXPERTS_PER_GROUP + e_local).reshape(-1).astype(jnp.int32)
    nk = n * EXPERT_TOPK
    order = jnp.argsort(expert_id)
    sorted_e = expert_id[order]
    counts = jnp.bincount(expert_id, length=N_EXPERTS)
    starts = jnp.cumsum(counts) - counts
    padded = ((counts + ROW_BLOCK - 1) // ROW_BLOCK) * ROW_BLOCK
    pad_end = jnp.cumsum(padded)
    pad_start = pad_end - padded
    dest = pad_start[sorted_e] + (jnp.arange(nk) - starts[sorted_e])
    cap = nk + N_EXPERTS * ROW_BLOCK
    n_blk = cap // ROW_BLOCK
    row_token = jnp.zeros((cap,), jnp.int32).at[dest].set((order // EXPERT_TOPK).astype(jnp.int32))
    row_gate = jnp.zeros((cap,), f32).at[dest].set(gates[order])
    blk_start = jnp.arange(n_blk) * ROW_BLOCK
    blk_e = jnp.minimum(jnp.sum(pad_end[None, :] <= blk_start[:, None], axis=1), N_EXPERTS - 1).astype(jnp.int32)
    xr = xt[row_token].reshape(n_blk, ROW_BLOCK, d)

    def expert_block(args):
        xb, e = args
        return (jax.nn.silu(xb @ w1[e]) * (xb @ w3[e])) @ w2[e]

    yr = lax.map(expert_block, (xr, blk_e)).reshape(cap, d)
    out = jnp.zeros((n, d), f32).at[row_token].add(yr.astype(f32) * row_gate[:, None])
    return out.astype(h.dtype).reshape(bsz, s, d)


def setup_inputs(seed: int = 0) -> dict:
    key = jax.random.key(seed)
    ks = jax.random.split(key, 24)
    f32 = jnp.float32

    def nrm(k, shape, scale):
        return jax.random.normal(k, shape, f32) * scale

    G, P, C = SSM_GROUPS, SSM_STATE, SSM_GROUP
    return {
        'x': nrm(ks[0], (BATCH, SEQ, D_MODEL), 1.0),
        'ln_mix': 1.0 + nrm(ks[1], (DEPTH, D_MODEL), 0.02),
        'ln_ffn': 1.0 + nrm(ks[2], (DEPTH, D_MODEL), 0.02),
        'ln_final': 1.0 + nrm(ks[3], (D_MODEL,), 0.02),
        'ssm_w_in': nrm(ks[4], (N_SSM_LAYERS, D_MODEL, SSM_WIDTH), D_MODEL ** -0.5),
        'ssm_lam_re': -0.5 + nrm(ks[5], (N_SSM_LAYERS, G, P), 0.01),
        'ssm_lam_im': math.pi * jnp.arange(P, dtype=f32) + nrm(ks[6], (N_SSM_LAYERS, G, P), 0.01),
        'ssm_log_dt': jax.random.uniform(ks[7], (N_SSM_LAYERS, G), f32, math.log(DT_MIN), math.log(DT_MAX)),
        'ssm_b_re': nrm(ks[8], (N_SSM_LAYERS, G, P, C), (2 * C) ** -0.5),
        'ssm_b_im': nrm(ks[9], (N_SSM_LAYERS, G, P, C), (2 * C) ** -0.5),
        'ssm_c_re': nrm(ks[10], (N_SSM_LAYERS, G, C, P), P ** -0.5),
        'ssm_c_im': nrm(ks[11], (N_SSM_LAYERS, G, C, P), P ** -0.5),
        'ssm_d': nrm(ks[12], (N_SSM_LAYERS, SSM_WIDTH), 0.5),
        'ssm_w_out': nrm(ks[13], (N_SSM_LAYERS, SSM_WIDTH, 2 * D_MODEL), SSM_WIDTH ** -0.5),
        'attn_w_qkv': nrm(ks[14], (N_ATTN_LAYERS, D_MODEL, 3 * ATT_HEADS * HEAD_DIM), D_MODEL ** -0.5),
        'attn_w_o': nrm(ks[15], (N_ATTN_LAYERS, ATT_HEADS * HEAD_DIM, D_MODEL), D_MODEL ** -0.5),
        'moe_w_group': nrm(ks[16], (DEPTH, D_MODEL, N_GROUPS), D_MODEL ** -0.5),
        'moe_w_expert': nrm(ks[17], (DEPTH, D_MODEL, N_EXPERTS), D_MODEL ** -0.5),
        'moe_w1': nrm(ks[18], (DEPTH, N_EXPERTS, D_MODEL, EXPERT_FF), D_MODEL ** -0.5),
        'moe_w3': nrm(ks[19], (DEPTH, N_EXPERTS, D_MODEL, EXPERT_FF), D_MODEL ** -0.5),
        'moe_w2': nrm(ks[20], (DEPTH, N_EXPERTS, EXPERT_FF, D_MODEL), EXPERT_FF ** -0.5),
    }


def reference(x, ln_mix, ln_ffn, ln_final, ssm_w_in, ssm_lam_re, ssm_lam_im, ssm_log_dt,
              ssm_b_re, ssm_b_im, ssm_c_re, ssm_c_im, ssm_d, ssm_w_out, attn_w_qkv, attn_w_o,
              moe_w_group, moe_w_expert, moe_w1, moe_w3, moe_w2):
    h = x
    for i in range(DEPTH):
        hn = rmsnorm(h, ln_mix[i])
        j = i // N_MIXERS
        if i % N_MIXERS == 0:
            mix = s5_mixer(hn, ssm_w_in[j], ssm_lam_re[j], ssm_lam_im[j], ssm_log_dt[j],
                           ssm_b_re[j], ssm_b_im[j], ssm_c_re[j], ssm_c_im[j], ssm_d[j], ssm_w_out[j])
        else:
            mix = moba_mixer(hn, attn_w_qkv[j], attn_w_o[j])
        h = h + mix
        h = h + hier_moe(rmsnorm(h, ln_ffn[i]), moe_w_group[i], moe_w_expert[i],
                         moe_w1[i], moe_w3[i], moe_w2[i])
    return rmsnorm(h, ln_final)
```

```cpp
#include <hip/hip_runtime.h>
#include <cstdint>
#include <cstdio>

#define DEVI __device__ __forceinline__
typedef unsigned short bf16_t;

constexpr int D = 1024, NB_ = 4, S = 4096, NTOK = NB_ * S;
constexpr int SG = 64, SC = 16, SP = 64;
constexpr int NH = 8, HD = 128, MBLK = 256, NBLK = S / MBLK, TOPK = 3;
constexpr int NGRP = 4, EPG = 8, NE = 32, FF = 512;
constexpr float EPS = 1e-6f;
constexpr int ECAP = 16384;
constexpr int MAXROWS = 40960;

constexpr size_t MiB = 1u << 20;
constexpr size_t WS_CTL = 0, CTL_BYTES = 1 * MiB;
constexpr size_t WS_TAB = 1 * MiB;
constexpr size_t WS_SLOT = 2 * MiB;
constexpr size_t WS_RTOK = 3 * MiB;
constexpr size_t WS_WD = 8 * MiB;
constexpr size_t WS_W13 = 24 * MiB;
constexpr size_t WS_W2 = 152 * MiB;
constexpr size_t WS_XN = 216 * MiB;
constexpr size_t WS_H = 248 * MiB;
constexpr size_t WS_MIX = 312 * MiB;
constexpr size_t WS_U = WS_MIX, WS_Z = WS_MIX + 64 * MiB;
constexpr size_t WS_Q = WS_MIX, WS_K = WS_MIX + 32 * MiB, WS_V = WS_MIX + 64 * MiB, WS_O = WS_MIX + 96 * MiB;
constexpr size_t WS_ACT = WS_MIX, WS_Y = WS_MIX + 40 * MiB;
constexpr size_t WS_END = 440 * MiB;
constexpr int CW_COUNT = 0;
constexpr int CW_BAR = 4096;
constexpr size_t CTL_KSUM = 512 * 1024;
constexpr int TAB_ABAR = 0;
constexpr int TAB_BB = 8192;

struct Slot { int epos; float gate; };

DEVI float bf2f(bf16_t b) { return __uint_as_float(((unsigned)b) << 16); }
DEVI bf16_t f2bf(float f) { unsigned u = __float_as_uint(f); u += 0x7fffu + ((u >> 16) & 1u); return (bf16_t)(u >> 16); }
DEVI float wave_sum(float v) {
#pragma unroll
    for (int o = 32; o >= 1; o >>= 1) v += __shfl_xor(v, o);
    return v;
}
DEVI float wave_max(float v) {
#pragma unroll
    for (int o = 32; o >= 1; o >>= 1) v = fmaxf(v, __shfl_xor(v, o));
    return v;
}
DEVI float sigmoidf_(float x) { return 1.f / (1.f + __expf(-x)); }
DEVI float gelu_tanh(float x) { const float t = tanhf(0.7978845608028654f * (x + 0.044715f * x * x * x)); return 0.5f * x * (1.f + t); }

__global__ void k_ssm_params(const float* lam_re, const float* lam_im, const float* log_dt, const float* b_re, const float* b_im, float* tab) {
    const int g = blockIdx.x, p = threadIdx.x;
    const float dt = expf(log_dt[g]);
    const float lr = fminf(lam_re[g * SP + p], -1e-4f), li = lam_im[g * SP + p];
    const float mag = expf(lr * dt), ar = mag * cosf(li * dt), ai = mag * sinf(li * dt);
    const float den = lr * lr + li * li, nr = ar - 1.f;
    const float gr = (nr * lr + ai * li) / den, gi = (ai * lr - nr * li) / den;
    tab[TAB_ABAR + (g * SP + p) * 2 + 0] = ar; tab[TAB_ABAR + (g * SP + p) * 2 + 1] = ai;
    for (int c = 0; c < SC; ++c) {
        const float br = b_re[(g * SP + p) * SC + c], bi = b_im[(g * SP + p) * SC + c];
        tab[TAB_BB + ((g * SP + p) * SC + c) * 2 + 0] = gr * br - gi * bi;
        tab[TAB_BB + ((g * SP + p) * SC + c) * 2 + 1] = gr * bi + gi * br;
    }
}

template <bool FROMX, bool COMBINE, bool ROUTER, bool FINAL>
__global__ __launch_bounds__(256) void k_tok(const float* Xin, float* H, const float* gain, bf16_t* XN, float* out,
                                             const bf16_t* Y, const Slot* slot_prev, const unsigned* cnt_prev,
                                             const float* w_group, const float* w_expert, Slot* slot, unsigned* cnt, int* row_token) {
    const int lane = threadIdx.x & 63, wid = threadIdx.x >> 6;
    const int tok = blockIdx.x * 4 + wid;
    const float* src = FROMX ? Xin : H;
    float4 v[4];
#pragma unroll
    for (int j = 0; j < 4; ++j) v[j] = *(const float4*)(src + (size_t)tok * D + 4 * lane + 256 * j);
    if (COMBINE) {
        int c = lane < NE ? (int)cnt_prev[lane] : 0; int pc = (c + 255) & ~255; int incl = pc;
#pragma unroll
        for (int o = 1; o < 32; o <<= 1) { int t = __shfl_up(incl, o); if ((lane & 31) >= o) incl += t; }
        const int excl = incl - pc;
#pragma unroll
        for (int k = 0; k < 2; ++k) {
            const Slot s = slot_prev[tok * 2 + k];
            const int e = s.epos >> 14, pos = s.epos & (ECAP - 1);
            const int rb = __shfl(excl, e);
            const bf16_t* yr = Y + (size_t)(rb + pos) * D;
#pragma unroll
            for (int j = 0; j < 4; ++j) {
                const uint2 w = *(const uint2*)(yr + 4 * lane + 256 * j);
                v[j].x += s.gate * __uint_as_float(w.x << 16); v[j].y += s.gate * __uint_as_float(w.x & 0xffff0000u);
                v[j].z += s.gate * __uint_as_float(w.y << 16); v[j].w += s.gate * __uint_as_float(w.y & 0xffff0000u);
            }
        }
        if (!FINAL) {
#pragma unroll
            for (int j = 0; j < 4; ++j) *(float4*)(H + (size_t)tok * D + 4 * lane + 256 * j) = v[j];
        }
    }
    float ss = 0.f;
#pragma unroll
    for (int j = 0; j < 4; ++j) ss += v[j].x * v[j].x + v[j].y * v[j].y + v[j].z * v[j].z + v[j].w * v[j].w;
    ss = wave_sum(ss);
    const float rstd = rsqrtf(ss * (1.f / D) + EPS);
#pragma unroll
    for (int j = 0; j < 4; ++j) {
        const float4 gg = *(const float4*)(gain + 4 * lane + 256 * j);
        v[j].x *= rstd * gg.x; v[j].y *= rstd * gg.y; v[j].z *= rstd * gg.z; v[j].w *= rstd * gg.w;
    }
    if (FINAL) {
#pragma unroll
        for (int j = 0; j < 4; ++j) *(float4*)(out + (size_t)tok * D + 4 * lane + 256 * j) = v[j];
    } else {
#pragma unroll
        for (int j = 0; j < 4; ++j) {
            uint2 w; w.x = (unsigned)f2bf(v[j].x) | ((unsigned)f2bf(v[j].y) << 16); w.y = (unsigned)f2bf(v[j].z) | ((unsigned)f2bf(v[j].w) << 16);
            *(uint2*)(XN + (size_t)tok * D + 4 * lane + 256 * j) = w;
        }
    }
    if (ROUTER) {
        float lg[NGRP], le[NE];
#pragma unroll
        for (int i = 0; i < NGRP; ++i) lg[i] = 0.f;
#pragma unroll
        for (int i = 0; i < NE; ++i) le[i] = 0.f;
#pragma unroll
        for (int j = 0; j < 4; ++j) {
            const float xv[4] = {v[j].x, v[j].y, v[j].z, v[j].w};
#pragma unroll
            for (int i = 0; i < 4; ++i) {
                const int k = 4 * lane + 256 * j + i;
                const float4 wg = *(const float4*)(w_group + (size_t)k * NGRP);
                lg[0] += xv[i] * wg.x; lg[1] += xv[i] * wg.y; lg[2] += xv[i] * wg.z; lg[3] += xv[i] * wg.w;
#pragma unroll
                for (int q = 0; q < 8; ++q) {
                    const float4 we = *(const float4*)(w_expert + (size_t)k * NE + 4 * q);
                    le[4 * q + 0] += xv[i] * we.x; le[4 * q + 1] += xv[i] * we.y; le[4 * q + 2] += xv[i] * we.z; le[4 * q + 3] += xv[i] * we.w;
                }
            }
        }
#pragma unroll
        for (int i = 0; i < NGRP; ++i) lg[i] = wave_sum(lg[i]);
#pragma unroll
        for (int i = 0; i < NE; ++i) le[i] = wave_sum(le[i]);
        int gi = 0; float gm = lg[0];
#pragma unroll
        for (int i = 1; i < NGRP; ++i) if (lg[i] > gm) { gm = lg[i]; gi = i; }
        float gs = 0.f;
#pragma unroll
        for (int i = 0; i < NGRP; ++i) gs += __expf(lg[i] - gm);
        const float g_gate = 1.f / gs;
        float ev[EPG];
#pragma unroll
        for (int i = 0; i < EPG; ++i) { float t = le[i];
#pragma unroll
            for (int q = 1; q < NGRP; ++q) t = (gi == q) ? le[q * EPG + i] : t;
            ev[i] = t; }
        int i0 = 0; float m0 = ev[0];
#pragma unroll
        for (int i = 1; i < EPG; ++i) if (ev[i] > m0) { m0 = ev[i]; i0 = i; }
        int i1 = -1; float m1 = -3.0e38f;
#pragma unroll
        for (int i = 0; i < EPG; ++i) if (i != i0 && ev[i] > m1) { m1 = ev[i]; i1 = i; }
        const float p1 = __expf(m1 - m0);
        const float g0 = g_gate / (1.f + p1), g1 = g_gate * p1 / (1.f + p1);
        if (lane == 0) {
            const int e0 = gi * EPG + i0, e1 = gi * EPG + i1;
            const int pos0 = (int)atomicAdd(&cnt[e0], 1u), pos1 = (int)atomicAdd(&cnt[e1], 1u);
            slot[tok * 2 + 0].epos = e0 * ECAP + pos0; slot[tok * 2 + 0].gate = g0;
            slot[tok * 2 + 1].epos = e1 * ECAP + pos1; slot[tok * 2 + 1].gate = g1;
            row_token[e0 * ECAP + pos0] = tok; row_token[e1 * ECAP + pos1] = tok;
        }
    }
}

template <class F, bool DUAL>
__global__ __launch_bounds__(256) void k_gemm_naive(F f) {
    __shared__ float As[16][68];
    __shared__ float B0s[16][64];
    __shared__ float B1s[16][64];
    __shared__ int sh_ctx[4];
    const int tid = threadIdx.x, tx = tid & 15, ty = tid >> 4;
    const int rt = blockIdx.y, col0 = blockIdx.x * 64;
    if (tid == 0) f.setup(rt, sh_ctx);
    __syncthreads();
    if (sh_ctx[0] < 0) return;
    const int c0 = sh_ctx[0], c1 = sh_ctx[1], c2 = sh_ctx[2];
    const float* b0 = f.b0(c0); const float* b1 = DUAL ? f.b1(c0) : nullptr;
    const int ldb = f.ldb(), K = f.K();
    float acc0[4][4], acc1[4][4];
#pragma unroll
    for (int i = 0; i < 4; ++i)
#pragma unroll
        for (int j = 0; j < 4; ++j) { acc0[i][j] = 0.f; acc1[i][j] = 0.f; }
    for (int k0 = 0; k0 < K; k0 += 16) {
#pragma unroll
        for (int i = 0; i < 4; ++i) { const int e = tid + 256 * i, r = e >> 4, kk = e & 15; As[kk][r] = f.a(rt, r, k0 + kk, c0, c1, c2); }
#pragma unroll
        for (int i = 0; i < 4; ++i) { const int e = tid + 256 * i, kk = e >> 6, c = e & 63; B0s[kk][c] = b0[(size_t)(k0 + kk) * ldb + col0 + c]; if (DUAL) B1s[kk][c] = b1[(size_t)(k0 + kk) * ldb + col0 + c]; }
        __syncthreads();
#pragma unroll
        for (int kk = 0; kk < 16; ++kk) {
            float a[4], b[4], bb[4];
#pragma unroll
            for (int i = 0; i < 4; ++i) a[i] = As[kk][ty * 4 + i];
#pragma unroll
            for (int j = 0; j < 4; ++j) { b[j] = B0s[kk][tx * 4 + j]; bb[j] = DUAL ? B1s[kk][tx * 4 + j] : 0.f; }
#pragma unroll
            for (int i = 0; i < 4; ++i)
#pragma unroll
                for (int j = 0; j < 4; ++j) { acc0[i][j] += a[i] * b[j]; if (DUAL) acc1[i][j] += a[i] * bb[j]; }
        }
        __syncthreads();
    }
#pragma unroll
    for (int i = 0; i < 4; ++i)
#pragma unroll
        for (int j = 0; j < 4; ++j) f.epi(rt, ty * 4 + i, col0 + tx * 4 + j, acc0[i][j], acc1[i][j], c0, c1, c2);
}

struct FWin {
    const bf16_t* XN; const float* W; float* U;
    DEVI void setup(int, int* c) const { c[0] = 0; }
    DEVI const float* b0(int) const { return W; } DEVI const float* b1(int) const { return nullptr; }
    DEVI int ldb() const { return D; } DEVI int K() const { return D; }
    DEVI float a(int rt, int r, int k, int, int, int) const { return bf2f(XN[(size_t)(rt * 64 + r) * D + k]); }
    DEVI void epi(int rt, int r, int col, float v0, float, int, int, int) const {
        const int row = rt * 64 + r, b = row / S, t = row % S, g = col >> 4, c = col & 15;
        U[(((size_t)b * SG + g) * S + t) * SC + c] = v0;
    }
};
struct FWout {
    const bf16_t* Z; const float* W; const float* X; float* H;
    DEVI void setup(int, int* c) const { c[0] = 0; }
    DEVI const float* b0(int) const { return W; } DEVI const float* b1(int) const { return W + D; }
    DEVI int ldb() const { return 2 * D; } DEVI int K() const { return D; }
    DEVI float a(int rt, int r, int k, int, int, int) const { const int row = rt * 64 + r, b = row / S, t = row % S; return bf2f(Z[(((size_t)b * SG + (k >> 4)) * S + t) * SC + (k & 15)]); }
    DEVI void epi(int rt, int r, int col, float v0, float v1, int, int, int) const {
        const size_t o = (size_t)(rt * 64 + r) * D + col; H[o] = X[o] + v0 * sigmoidf_(v1);
    }
};
DEVI void expert_of_rowtile(const unsigned* cnt, int row0, int* c) {
    int base = 0; c[0] = -1; c[1] = 0; c[2] = 0;
    for (int i = 0; i < NE; ++i) { const int n = (int)cnt[i], pc = (n + 255) & ~255; if (row0 < base + pc) { c[0] = i; c[1] = base; c[2] = n; return; } base += pc; }
}
struct FMoe1 {
    const bf16_t* XN; const float* W1; const float* W3; const unsigned* cnt; const int* row_token; bf16_t* ACT;
    DEVI void setup(int rt, int* c) const { expert_of_rowtile(cnt, rt * 64, c); }
    DEVI const float* b0(int e) const { return W1 + (size_t)e * D * FF; } DEVI const float* b1(int e) const { return W3 + (size_t)e * D * FF; }
    DEVI int ldb() const { return FF; } DEVI int K() const { return D; }
    DEVI float a(int rt, int r, int k, int e, int base, int n) const { const int pos = rt * 64 + r - base; const int tok = pos < n ? row_token[e * ECAP + pos] : 0; return bf2f(XN[(size_t)tok * D + k]); }
    DEVI void epi(int rt, int r, int col, float v0, float v1, int, int, int) const { ACT[(size_t)(rt * 64 + r) * FF + col] = f2bf(v0 * sigmoidf_(v0) * v1); }
};
struct FMoe2 {
    const bf16_t* ACT; const float* W2; const unsigned* cnt; bf16_t* Y;
    DEVI void setup(int rt, int* c) const { expert_of_rowtile(cnt, rt * 64, c); }
    DEVI const float* b0(int e) const { return W2 + (size_t)e * FF * D; } DEVI const float* b1(int) const { return nullptr; }
    DEVI int ldb() const { return D; } DEVI int K() const { return FF; }
    DEVI float a(int rt, int r, int k, int, int, int) const { return bf2f(ACT[(size_t)(rt * 64 + r) * FF + k]); }
    DEVI void epi(int rt, int r, int col, float v0, float, int, int, int) const { Y[(size_t)(rt * 64 + r) * D + col] = f2bf(v0); }
};
struct FQkv {
    const bf16_t* XN; const float* W; bf16_t* Q;
    DEVI void setup(int, int* c) const { c[0] = 0; }
    DEVI const float* b0(int) const { return W; } DEVI const float* b1(int) const { return nullptr; }
    DEVI int ldb() const { return 3 * D; } DEVI int K() const { return D; }
    DEVI float a(int rt, int r, int k, int, int, int) const { return bf2f(XN[(size_t)(rt * 64 + r) * D + k]); }
    DEVI void epi(int rt, int r, int col, float v0, float, int, int, int) const {
        const int row = rt * 64 + r, b = row / S, t = row % S, which = col >> 10, h = (col & 1023) >> 7, d = col & 127;
        Q[(size_t)which * ((size_t)NTOK * D) + (((size_t)b * NH + h) * S + t) * HD + d] = f2bf(v0);
    }
};
struct FWo {
    const bf16_t* O; const float* W; float* H;
    DEVI void setup(int, int* c) const { c[0] = 0; }
    DEVI const float* b0(int) const { return W; } DEVI const float* b1(int) const { return nullptr; }
    DEVI int ldb() const { return D; } DEVI int K() const { return D; }
    DEVI float a(int rt, int r, int k, int, int, int) const { return bf2f(O[(size_t)(rt * 64 + r) * D + k]); }
    DEVI void epi(int rt, int r, int col, float v0, float, int, int, int) const { H[(size_t)(rt * 64 + r) * D + col] += v0; }
};

__global__ __launch_bounds__(64) void k_ssm_naive(const float* U, const float* tab, const float* c_re, const float* c_im, const float* d_skip, bf16_t* Z) {
    __shared__ float xs[64][130];
    __shared__ float us[64][16];
    __shared__ float cr[16][64], ci[16][64];
    const int bg = blockIdx.x, g = bg % SG, p = threadIdx.x;
    float bbr[SC], bbi[SC];
#pragma unroll
    for (int c = 0; c < SC; ++c) { bbr[c] = tab[TAB_BB + ((g * SP + p) * SC + c) * 2]; bbi[c] = tab[TAB_BB + ((g * SP + p) * SC + c) * 2 + 1]; }
    const float ar = tab[TAB_ABAR + (g * SP + p) * 2], ai = tab[TAB_ABAR + (g * SP + p) * 2 + 1];
    for (int i = p; i < 16 * 64; i += 64) { cr[i / 64][i % 64] = c_re[(size_t)g * 1024 + i]; ci[i / 64][i % 64] = c_im[(size_t)g * 1024 + i]; }
    float dsk[SC];
#pragma unroll
    for (int c = 0; c < SC; ++c) dsk[c] = d_skip[g * SC + c];
    float xr = 0.f, xi = 0.f;
    const float* Ub = U + (size_t)bg * S * SC;
    bf16_t* Zb = Z + (size_t)bg * S * SC;
    for (int t0 = 0; t0 < S; t0 += 64) {
        __syncthreads();
        for (int i = p; i < 64 * 16; i += 64) us[i / 16][i % 16] = Ub[(size_t)t0 * SC + i];
        __syncthreads();
        for (int t = 0; t < 64; ++t) {
            float br = 0.f, bi = 0.f;
#pragma unroll
            for (int c = 0; c < SC; ++c) { const float u = us[t][c]; br += u * bbr[c]; bi += u * bbi[c]; }
            const float nr = ar * xr - ai * xi + br, ni = ar * xi + ai * xr + bi;
            xr = nr; xi = ni; xs[t][2 * p] = xr; xs[t][2 * p + 1] = xi;
        }
        __syncthreads();
        const int t = p;
        float y[SC];
#pragma unroll
        for (int c = 0; c < SC; ++c) y[c] = 0.f;
        for (int q = 0; q < SP; ++q) { const float a = xs[t][2 * q], b = xs[t][2 * q + 1];
#pragma unroll
            for (int c = 0; c < SC; ++c) y[c] += a * cr[c][q] - b * ci[c][q]; }
#pragma unroll
        for (int c = 0; c < SC; ++c) { const float v = y[c] + dsk[c] * us[t][c]; Zb[(size_t)(t0 + t) * SC + c] = f2bf(gelu_tanh(v)); }
    }
}

__global__ __launch_bounds__(256) void k_ksum_naive(const bf16_t* Kb, float* KSUM) {
    const int bhn = blockIdx.x, bh = bhn / NBLK, n = bhn % NBLK, d = threadIdx.x;
    if (d >= HD) return;
    float s = 0.f;
    for (int j = 0; j < MBLK; ++j) s += bf2f(Kb[((size_t)bh * S + n * MBLK + j) * HD + d]);
    KSUM[(size_t)bhn * HD + d] = s;
}
__global__ __launch_bounds__(256) void k_attn_naive(const bf16_t* Q, const bf16_t* Kb, const bf16_t* Vb, const float* KSUM, bf16_t* O) {
    __shared__ float qs[4][HD];
    __shared__ float sc[4][1024];
    const int lane = threadIdx.x & 63, wid = threadIdx.x >> 6;
    const int gq = blockIdx.x * 4 + wid;
    const int bh = gq / S, s = gq % S, cur = s / MBLK;
    const bf16_t* qp = Q + (size_t)gq * HD;
    qs[wid][lane] = bf2f(qp[lane]); qs[wid][lane + 64] = bf2f(qp[lane + 64]);
    __syncthreads();
    float gate[NBLK];
#pragma unroll
    for (int n = 0; n < NBLK; ++n) {
        float t = 0.f;
        if (n < cur) t = qs[wid][lane] * KSUM[((size_t)bh * NBLK + n) * HD + lane] + qs[wid][lane + 64] * KSUM[((size_t)bh * NBLK + n) * HD + lane + 64];
        t = wave_sum(t) * (1.f / MBLK);
        gate[n] = n < cur ? t : -1e30f;
    }
    unsigned blkpack = 0; int nsel = 0;
    unsigned used = 0;
    for (int k = 0; k < TOPK; ++k) {
        int bi = -1; float bm = -3.0e38f;
#pragma unroll
        for (int n = 0; n < NBLK; ++n) if (!((used >> n) & 1u) && gate[n] > bm) { bm = gate[n]; bi = n; }
        used |= 1u << bi;
        if (bi < cur) { blkpack |= (unsigned)bi << (4 * nsel); ++nsel; }
    }
    blkpack |= (unsigned)cur << (4 * nsel); ++nsel;
    const float scale = 0.08838834764831845f;
    float mx = -3.0e38f;
    for (int i = 0; i < nsel; ++i) {
        const int n = (int)((blkpack >> (4 * i)) & 15u);
        for (int j = lane; j < MBLK; j += 64) {
            const int key = n * MBLK + j;
            const bf16_t* kp = Kb + ((size_t)bh * S + key) * HD;
            float a = 0.f;
            for (int d = 0; d < HD; d += 8) {
                const uint4 w = *(const uint4*)(kp + d);
                a += qs[wid][d] * __uint_as_float(w.x << 16) + qs[wid][d + 1] * __uint_as_float(w.x & 0xffff0000u)
                   + qs[wid][d + 2] * __uint_as_float(w.y << 16) + qs[wid][d + 3] * __uint_as_float(w.y & 0xffff0000u)
                   + qs[wid][d + 4] * __uint_as_float(w.z << 16) + qs[wid][d + 5] * __uint_as_float(w.z & 0xffff0000u)
                   + qs[wid][d + 6] * __uint_as_float(w.w << 16) + qs[wid][d + 7] * __uint_as_float(w.w & 0xffff0000u);
            }
            a *= scale;
            if (key > s) a = -1e30f;
            sc[wid][i * MBLK + j] = a;
            mx = fmaxf(mx, a);
        }
    }
    mx = wave_max(mx);
    float sum = 0.f;
    for (int j = lane; j < nsel * MBLK; j += 64) { const float pv = __expf(sc[wid][j] - mx); sc[wid][j] = pv; sum += pv; }
    sum = wave_sum(sum);
    __syncthreads();
    float o0 = 0.f, o1 = 0.f;
    for (int i = 0; i < nsel; ++i) {
        const int n = (int)((blkpack >> (4 * i)) & 15u);
        for (int j = 0; j < MBLK; ++j) {
            const float pv = sc[wid][i * MBLK + j];
            const unsigned w = *(const unsigned*)(Vb + ((size_t)bh * S + n * MBLK + j) * HD + 2 * lane);
            o0 += pv * __uint_as_float(w << 16); o1 += pv * __uint_as_float(w & 0xffff0000u);
        }
    }
    const float inv = 1.f / sum;
    const int b = bh / NH, h = bh % NH;
    const unsigned w = (unsigned)f2bf(o0 * inv) | ((unsigned)f2bf(o1 * inv) << 16);
    *(unsigned*)(O + ((size_t)b * S + s) * D + h * HD + 2 * lane) = w;
}

extern "C" void kernel_launch(void* const* d_in, const int* in_sizes, int n_in, void* d_out, int out_size, void* d_ws, size_t ws_size, hipStream_t stream) {
    if (n_in != 21 || in_sizes[0] != NTOK * D || out_size != NTOK * D || ws_size < WS_END) {
        fprintf(stderr, "kernel_launch: unexpected shapes (n_in %d, in0 %d, out %d, ws %zu)\n", n_in, n_in > 0 ? in_sizes[0] : -1, out_size, ws_size); return; }
    const float* x = (const float*)d_in[0]; const float* ln_mix = (const float*)d_in[1]; const float* ln_ffn = (const float*)d_in[2]; const float* ln_final = (const float*)d_in[3];
    const float* w_in = (const float*)d_in[4]; const float* lam_re = (const float*)d_in[5]; const float* lam_im = (const float*)d_in[6]; const float* log_dt = (const float*)d_in[7];
    const float* b_re = (const float*)d_in[8]; const float* b_im = (const float*)d_in[9]; const float* c_re = (const float*)d_in[10]; const float* c_im = (const float*)d_in[11];
    const float* ssm_d = (const float*)d_in[12]; const float* w_out = (const float*)d_in[13]; const float* w_qkv = (const float*)d_in[14]; const float* w_o = (const float*)d_in[15];
    const float* w_group = (const float*)d_in[16]; const float* w_expert = (const float*)d_in[17]; const float* w1 = (const float*)d_in[18]; const float* w3 = (const float*)d_in[19]; const float* w2 = (const float*)d_in[20];
    unsigned char* ws = (unsigned char*)d_ws; float* out = (float*)d_out;
    unsigned* ctl = (unsigned*)(ws + WS_CTL); float* KSUM = (float*)(ws + WS_CTL + CTL_KSUM); float* tab = (float*)(ws + WS_TAB);
    Slot* slot = (Slot*)(ws + WS_SLOT); int* rtok = (int*)(ws + WS_RTOK);
    bf16_t* XN = (bf16_t*)(ws + WS_XN); float* H = (float*)(ws + WS_H);
    float* U = (float*)(ws + WS_U); bf16_t* Z = (bf16_t*)(ws + WS_Z);
    bf16_t* Q = (bf16_t*)(ws + WS_Q); bf16_t* Kb = (bf16_t*)(ws + WS_K); bf16_t* Vb = (bf16_t*)(ws + WS_V); bf16_t* O = (bf16_t*)(ws + WS_O);
    bf16_t* ACT = (bf16_t*)(ws + WS_ACT); bf16_t* Y = (bf16_t*)(ws + WS_Y);
    (void)hipMemsetAsync(ws + WS_CTL, 0, CTL_BYTES, stream);
    k_ssm_params<<<SG, SP, 0, stream>>>(lam_re, lam_im, log_dt, b_re, b_im, tab);
    k_tok<true, false, false, false><<<NTOK / 4, 256, 0, stream>>>(x, nullptr, ln_mix, XN, nullptr, nullptr, nullptr, nullptr, nullptr, nullptr, nullptr, nullptr, nullptr);
    k_gemm_naive<FWin, false><<<dim3(D / 64, NTOK / 64), 256, 0, stream>>>(FWin{XN, w_in, U});
    k_ssm_naive<<<NB_ * SG, 64, 0, stream>>>(U, tab, c_re, c_im, ssm_d, Z);
    k_gemm_naive<FWout, true><<<dim3(D / 64, NTOK / 64), 256, 0, stream>>>(FWout{Z, w_out, x, H});
    for (int layer = 0; layer < 2; ++layer) {
        unsigned* cnt = ctl + CW_COUNT + 32 * layer;
        if (layer == 1) {
            k_tok<false, true, false, false><<<NTOK / 4, 256, 0, stream>>>(nullptr, H, ln_mix + D, XN, nullptr, Y, slot, ctl + CW_COUNT, nullptr, nullptr, nullptr, nullptr, nullptr);
            k_gemm_naive<FQkv, false><<<dim3(3 * D / 64, NTOK / 64), 256, 0, stream>>>(FQkv{XN, w_qkv, Q});
            k_ksum_naive<<<NB_ * NH * NBLK, 128, 0, stream>>>(Kb, KSUM);
            k_attn_naive<<<NB_ * NH * S / 4, 256, 0, stream>>>(Q, Kb, Vb, KSUM, O);
            k_gemm_naive<FWo, false><<<dim3(D / 64, NTOK / 64), 256, 0, stream>>>(FWo{O, w_o, H});
        }
        k_tok<false, false, true, false><<<NTOK / 4, 256, 0, stream>>>(nullptr, H, ln_ffn + layer * D, XN, nullptr, nullptr, nullptr, nullptr,
                                                                      w_group + (size_t)layer * D * NGRP, w_expert + (size_t)layer * D * NE, slot, cnt, rtok);
        k_gemm_naive<FMoe1, true><<<dim3(FF / 64, MAXROWS / 64), 256, 0, stream>>>(FMoe1{XN, w1 + (size_t)layer * NE * D * FF, w3 + (size_t)layer * NE * D * FF, cnt, rtok, ACT});
        k_gemm_naive<FMoe2, false><<<dim3(D / 64, MAXROWS / 64), 256, 0, stream>>>(FMoe2{ACT, w2 + (size_t)layer * NE * FF * D, cnt, Y});
    }
    k_tok<false, true, false, true><<<NTOK / 4, 256, 0, stream>>>(nullptr, H, ln_final, nullptr, out, Y, slot, ctl + CW_COUNT + 32, nullptr, nullptr, nullptr, nullptr, nullptr);
}
```

```cpp
#include <hip/hip_runtime.h>
#include <cstdint>
#include <cstdio>

#define DEVI __device__ __forceinline__
typedef unsigned short bf16_t;

constexpr int D = 1024, NB_ = 4, S = 4096, NTOK = NB_ * S;
constexpr int SG = 64, SC = 16, SP = 64;
constexpr int NH = 8, HD = 128, MBLK = 256, NBLK = S / MBLK, TOPK = 3;
constexpr int NGRP = 4, EPG = 8, NE = 32, FF = 512;
constexpr float EPS = 1e-6f;
constexpr int ECAP = 16384;
constexpr int MAXROWS = 40960;

constexpr size_t MiB = 1u << 20;
constexpr size_t WS_CTL = 0, CTL_BYTES = 1 * MiB;
constexpr size_t WS_TAB = 1 * MiB;
constexpr size_t WS_SLOT = 2 * MiB;
constexpr size_t WS_RTOK = 3 * MiB;
constexpr size_t WS_TAB2 = 5 * MiB;
constexpr size_t WS_WD = 8 * MiB;
constexpr size_t WS_W13 = 24 * MiB;
constexpr size_t WS_W2 = 152 * MiB;
constexpr size_t WS_XN = 216 * MiB;
constexpr size_t WS_H = 248 * MiB;
constexpr size_t WS_MIX = 312 * MiB;
constexpr size_t WS_U = WS_MIX, WS_Z = WS_MIX + 64 * MiB;
constexpr size_t WS_Q = WS_MIX, WS_K = WS_MIX + 32 * MiB, WS_V = WS_MIX + 64 * MiB, WS_O = WS_MIX + 96 * MiB;
constexpr size_t WS_ACT = WS_MIX, WS_Y = WS_MIX + 40 * MiB;
constexpr size_t WS_END = 440 * MiB;
constexpr int CW_COUNT = 0;
constexpr int CW_BAR = 4096;
constexpr size_t CTL_KSUM = 512 * 1024;
constexpr int TAB_ABAR = 0;
constexpr int TAB_BB = 8192;

struct Slot { int epos; float gate; };

DEVI float bf2f(bf16_t b) { return __uint_as_float(((unsigned)b) << 16); }
DEVI bf16_t f2bf(float f) { unsigned u = __float_as_uint(f); u += 0x7fffu + ((u >> 16) & 1u); return (bf16_t)(u >> 16); }
DEVI float wave_sum(float v) {
#pragma unroll
    for (int o = 32; o >= 1; o >>= 1) v += __shfl_xor(v, o);
    return v;
}
DEVI float wave_max(float v) {
#pragma unroll
    for (int o = 32; o >= 1; o >>= 1) v = fmaxf(v, __shfl_xor(v, o));
    return v;
}
DEVI float sigmoidf_(float x) { return 1.f / (1.f + __expf(-x)); }
DEVI float gelu_tanh(float x) { const float t = tanhf(0.7978845608028654f * (x + 0.044715f * x * x * x)); return 0.5f * x * (1.f + t); }

__global__ void k_ssm_params(const float* lam_re, const float* lam_im, const float* log_dt, const float* b_re, const float* b_im, float* tab) {
    const int g = blockIdx.x, p = threadIdx.x;
    const float dt = expf(log_dt[g]);
    const float lr = fminf(lam_re[g * SP + p], -1e-4f), li = lam_im[g * SP + p];
    const float mag = expf(lr * dt), ar = mag * cosf(li * dt), ai = mag * sinf(li * dt);
    const float den = lr * lr + li * li, nr = ar - 1.f;
    const float gr = (nr * lr + ai * li) / den, gi = (ai * lr - nr * li) / den;
    tab[TAB_ABAR + (g * SP + p) * 2 + 0] = ar; tab[TAB_ABAR + (g * SP + p) * 2 + 1] = ai;
    for (int c = 0; c < SC; ++c) {
        const float br = b_re[(g * SP + p) * SC + c], bi = b_im[(g * SP + p) * SC + c];
        tab[TAB_BB + ((g * SP + p) * SC + c) * 2 + 0] = gr * br - gi * bi;
        tab[TAB_BB + ((g * SP + p) * SC + c) * 2 + 1] = gr * bi + gi * br;
    }
}

template <bool FROMX, bool COMBINE, bool ROUTER, bool FINAL>
DEVI void tok_row(int tok, int lane, const float* Xin, float* H, const float* gain, bf16_t* XN, float* out,
                  const bf16_t* Y, const Slot* slot_prev, const unsigned* cnt_prev,
                  const float* w_group, const float* w_expert, Slot* slot, unsigned* cnt, int* row_token) {
    const float* src = FROMX ? Xin : H;
    float4 v[4];
#pragma unroll
    for (int j = 0; j < 4; ++j) v[j] = *(const float4*)(src + (size_t)tok * D + 4 * lane + 256 * j);
    if (COMBINE) {
        int c = lane < NE ? (int)cnt_prev[lane] : 0; int pc = (c + 255) & ~255; int incl = pc;
#pragma unroll
        for (int o = 1; o < 32; o <<= 1) { int t = __shfl_up(incl, o); if ((lane & 31) >= o) incl += t; }
        const int excl = incl - pc;
#pragma unroll
        for (int k = 0; k < 2; ++k) {
            const Slot s = slot_prev[tok * 2 + k];
            const int e = s.epos >> 14, pos = s.epos & (ECAP - 1);
            const int rb = __shfl(excl, e);
            const bf16_t* yr = Y + (size_t)(rb + pos) * D;
#pragma unroll
            for (int j = 0; j < 4; ++j) {
                const uint2 w = *(const uint2*)(yr + 4 * lane + 256 * j);
                v[j].x += s.gate * __uint_as_float(w.x << 16); v[j].y += s.gate * __uint_as_float(w.x & 0xffff0000u);
                v[j].z += s.gate * __uint_as_float(w.y << 16); v[j].w += s.gate * __uint_as_float(w.y & 0xffff0000u);
            }
        }
        if (!FINAL) {
#pragma unroll
            for (int j = 0; j < 4; ++j) *(float4*)(H + (size_t)tok * D + 4 * lane + 256 * j) = v[j];
        }
    }
    float ss = 0.f;
#pragma unroll
    for (int j = 0; j < 4; ++j) ss += v[j].x * v[j].x + v[j].y * v[j].y + v[j].z * v[j].z + v[j].w * v[j].w;
    ss = wave_sum(ss);
    const float rstd = rsqrtf(ss * (1.f / D) + EPS);
#pragma unroll
    for (int j = 0; j < 4; ++j) {
        const float4 gg = *(const float4*)(gain + 4 * lane + 256 * j);
        v[j].x *= rstd * gg.x; v[j].y *= rstd * gg.y; v[j].z *= rstd * gg.z; v[j].w *= rstd * gg.w;
    }
    if (FINAL) {
#pragma unroll
        for (int j = 0; j < 4; ++j) *(float4*)(out + (size_t)tok * D + 4 * lane + 256 * j) = v[j];
    } else {
#pragma unroll
        for (int j = 0; j < 4; ++j) {
            uint2 w; w.x = (unsigned)f2bf(v[j].x) | ((unsigned)f2bf(v[j].y) << 16); w.y = (unsigned)f2bf(v[j].z) | ((unsigned)f2bf(v[j].w) << 16);
            *(uint2*)(XN + (size_t)tok * D + 4 * lane + 256 * j) = w;
        }
    }
    if (ROUTER) {
        float lg[NGRP], le[NE];
#pragma unroll
        for (int i = 0; i < NGRP; ++i) lg[i] = 0.f;
#pragma unroll
        for (int i = 0; i < NE; ++i) le[i] = 0.f;
#pragma unroll
        for (int j = 0; j < 4; ++j) {
            const float xv[4] = {v[j].x, v[j].y, v[j].z, v[j].w};
#pragma unroll
            for (int i = 0; i < 4; ++i) {
                const int k = 4 * lane + 256 * j + i;
                const float4 wg = *(const float4*)(w_group + (size_t)k * NGRP);
                lg[0] += xv[i] * wg.x; lg[1] += xv[i] * wg.y; lg[2] += xv[i] * wg.z; lg[3] += xv[i] * wg.w;
#pragma unroll
                for (int q = 0; q < 8; ++q) {
                    const float4 we = *(const float4*)(w_expert + (size_t)k * NE + 4 * q);
                    le[4 * q + 0] += xv[i] * we.x; le[4 * q + 1] += xv[i] * we.y; le[4 * q + 2] += xv[i] * we.z; le[4 * q + 3] += xv[i] * we.w;
                }
            }
        }
#pragma unroll
        for (int i = 0; i < NGRP; ++i) lg[i] = wave_sum(lg[i]);
#pragma unroll
        for (int i = 0; i < NE; ++i) le[i] = wave_sum(le[i]);
        int gi = 0; float gm = lg[0];
#pragma unroll
        for (int i = 1; i < NGRP; ++i) if (lg[i] > gm) { gm = lg[i]; gi = i; }
        float gs = 0.f;
#pragma unroll
        for (int i = 0; i < NGRP; ++i) gs += __expf(lg[i] - gm);
        const float g_gate = 1.f / gs;
        float ev[EPG];
#pragma unroll
        for (int i = 0; i < EPG; ++i) { float t = le[i];
#pragma unroll
            for (int q = 1; q < NGRP; ++q) t = (gi == q) ? le[q * EPG + i] : t;
            ev[i] = t; }
        int i0 = 0; float m0 = ev[0];
#pragma unroll
        for (int i = 1; i < EPG; ++i) if (ev[i] > m0) { m0 = ev[i]; i0 = i; }
        int i1 = -1; float m1 = -3.0e38f;
#pragma unroll
        for (int i = 0; i < EPG; ++i) if (i != i0 && ev[i] > m1) { m1 = ev[i]; i1 = i; }
        const float p1 = __expf(m1 - m0);
        const float g0 = g_gate / (1.f + p1), g1 = g_gate * p1 / (1.f + p1);
        if (lane == 0) {
            const int e0 = gi * EPG + i0, e1 = gi * EPG + i1;
            const int pos0 = (int)atomicAdd(&cnt[e0], 1u), pos1 = (int)atomicAdd(&cnt[e1], 1u);
            slot[tok * 2 + 0].epos = e0 * ECAP + pos0; slot[tok * 2 + 0].gate = g0;
            slot[tok * 2 + 1].epos = e1 * ECAP + pos1; slot[tok * 2 + 1].gate = g1;
            row_token[e0 * ECAP + pos0] = tok; row_token[e1 * ECAP + pos1] = tok;
        }
    }
}

template <bool FROMX, bool COMBINE, bool ROUTER, bool FINAL>
__global__ __launch_bounds__(256) void k_tok(const float* Xin, float* H, const float* gain, bf16_t* XN, float* out,
                                             const bf16_t* Y, const Slot* slot_prev, const unsigned* cnt_prev,
                                             const float* w_group, const float* w_expert, Slot* slot, unsigned* cnt, int* row_token) {
    tok_row<FROMX, COMBINE, ROUTER, FINAL>(blockIdx.x * 4 + (threadIdx.x >> 6), threadIdx.x & 63, Xin, H, gain, XN, out, Y, slot_prev, cnt_prev, w_group, w_expert, slot, cnt, row_token);
}

template <class F, bool DUAL>
__global__ __launch_bounds__(256) void k_gemm_naive(F f) {
    __shared__ float As[16][68];
    __shared__ float B0s[16][64];
    __shared__ float B1s[16][64];
    __shared__ int sh_ctx[4];
    const int tid = threadIdx.x, tx = tid & 15, ty = tid >> 4;
    const int rt = blockIdx.y, col0 = blockIdx.x * 64;
    if (tid == 0) f.setup(rt, sh_ctx);
    __syncthreads();
    if (sh_ctx[0] < 0) return;
    const int c0 = sh_ctx[0], c1 = sh_ctx[1], c2 = sh_ctx[2];
    const float* b0 = f.b0(c0); const float* b1 = DUAL ? f.b1(c0) : nullptr;
    const int ldb = f.ldb(), K = f.K();
    float acc0[4][4], acc1[4][4];
#pragma unroll
    for (int i = 0; i < 4; ++i)
#pragma unroll
        for (int j = 0; j < 4; ++j) { acc0[i][j] = 0.f; acc1[i][j] = 0.f; }
    for (int k0 = 0; k0 < K; k0 += 16) {
#pragma unroll
        for (int i = 0; i < 4; ++i) { const int e = tid + 256 * i, r = e >> 4, kk = e & 15; As[kk][r] = f.a(rt, r, k0 + kk, c0, c1, c2); }
#pragma unroll
        for (int i = 0; i < 4; ++i) { const int e = tid + 256 * i, kk = e >> 6, c = e & 63; B0s[kk][c] = b0[(size_t)(k0 + kk) * ldb + col0 + c]; if (DUAL) B1s[kk][c] = b1[(size_t)(k0 + kk) * ldb + col0 + c]; }
        __syncthreads();
#pragma unroll
        for (int kk = 0; kk < 16; ++kk) {
            float a[4], b[4], bb[4];
#pragma unroll
            for (int i = 0; i < 4; ++i) a[i] = As[kk][ty * 4 + i];
#pragma unroll
            for (int j = 0; j < 4; ++j) { b[j] = B0s[kk][tx * 4 + j]; bb[j] = DUAL ? B1s[kk][tx * 4 + j] : 0.f; }
#pragma unroll
            for (int i = 0; i < 4; ++i)
#pragma unroll
                for (int j = 0; j < 4; ++j) { acc0[i][j] += a[i] * b[j]; if (DUAL) acc1[i][j] += a[i] * bb[j]; }
        }
        __syncthreads();
    }
#pragma unroll
    for (int i = 0; i < 4; ++i)
#pragma unroll
        for (int j = 0; j < 4; ++j) f.epi(rt, ty * 4 + i, col0 + tx * 4 + j, acc0[i][j], acc1[i][j], c0, c1, c2);
}

struct FWin {
    const bf16_t* XN; const float* W; float* U;
    DEVI void setup(int, int* c) const { c[0] = 0; }
    DEVI const float* b0(int) const { return W; } DEVI const float* b1(int) const { return nullptr; }
    DEVI int ldb() const { return D; } DEVI int K() const { return D; }
    DEVI float a(int rt, int r, int k, int, int, int) const { return bf2f(XN[(size_t)(rt * 64 + r) * D + k]); }
    DEVI void epi(int rt, int r, int col, float v0, float, int, int, int) const {
        const int row = rt * 64 + r, b = row / S, t = row % S, g = col >> 4, c = col & 15;
        U[(((size_t)b * SG + g) * S + t) * SC + c] = v0;
    }
};
struct FWout {
    const bf16_t* Z; const float* W; const float* X; float* H;
    DEVI void setup(int, int* c) const { c[0] = 0; }
    DEVI const float* b0(int) const { return W; } DEVI const float* b1(int) const { return W + D; }
    DEVI int ldb() const { return 2 * D; } DEVI int K() const { return D; }
    DEVI float a(int rt, int r, int k, int, int, int) const { const int row = rt * 64 + r, b = row / S, t = row % S; return bf2f(Z[(((size_t)b * SG + (k >> 4)) * S + t) * SC + (k & 15)]); }
    DEVI void epi(int rt, int r, int col, float v0, float v1, int, int, int) const {
        const size_t o = (size_t)(rt * 64 + r) * D + col; H[o] = X[o] + v0 * sigmoidf_(v1);
    }
};
DEVI void expert_of_rowtile(const unsigned* cnt, int row0, int* c) {
    int base = 0; c[0] = -1; c[1] = 0; c[2] = 0;
    for (int i = 0; i < NE; ++i) { const int n = (int)cnt[i], pc = (n + 255) & ~255; if (row0 < base + pc) { c[0] = i; c[1] = base; c[2] = n; return; } base += pc; }
}
struct FMoe1 {
    const bf16_t* XN; const float* W1; const float* W3; const unsigned* cnt; const int* row_token; bf16_t* ACT;
    DEVI void setup(int rt, int* c) const { expert_of_rowtile(cnt, rt * 64, c); }
    DEVI const float* b0(int e) const { return W1 + (size_t)e * D * FF; } DEVI const float* b1(int e) const { return W3 + (size_t)e * D * FF; }
    DEVI int ldb() const { return FF; } DEVI int K() const { return D; }
    DEVI float a(int rt, int r, int k, int e, int base, int n) const { const int pos = rt * 64 + r - base; const int tok = pos < n ? row_token[e * ECAP + pos] : 0; return bf2f(XN[(size_t)tok * D + k]); }
    DEVI void epi(int rt, int r, int col, float v0, float v1, int, int, int) const { ACT[(size_t)(rt * 64 + r) * FF + col] = f2bf(v0 * sigmoidf_(v0) * v1); }
};
struct FMoe2 {
    const bf16_t* ACT; const float* W2; const unsigned* cnt; bf16_t* Y;
    DEVI void setup(int rt, int* c) const { expert_of_rowtile(cnt, rt * 64, c); }
    DEVI const float* b0(int e) const { return W2 + (size_t)e * FF * D; } DEVI const float* b1(int) const { return nullptr; }
    DEVI int ldb() const { return D; } DEVI int K() const { return FF; }
    DEVI float a(int rt, int r, int k, int, int, int) const { return bf2f(ACT[(size_t)(rt * 64 + r) * FF + k]); }
    DEVI void epi(int rt, int r, int col, float v0, float, int, int, int) const { Y[(size_t)(rt * 64 + r) * D + col] = f2bf(v0); }
};
struct FQkv {
    const bf16_t* XN; const float* W; bf16_t* Q;
    DEVI void setup(int, int* c) const { c[0] = 0; }
    DEVI const float* b0(int) const { return W; } DEVI const float* b1(int) const { return nullptr; }
    DEVI int ldb() const { return 3 * D; } DEVI int K() const { return D; }
    DEVI float a(int rt, int r, int k, int, int, int) const { return bf2f(XN[(size_t)(rt * 64 + r) * D + k]); }
    DEVI void epi(int rt, int r, int col, float v0, float, int, int, int) const {
        const int row = rt * 64 + r, b = row / S, t = row % S, which = col >> 10, h = (col & 1023) >> 7, d = col & 127;
        Q[(size_t)which * ((size_t)NTOK * D) + (((size_t)b * NH + h) * S + t) * HD + d] = f2bf(v0);
    }
};
struct FWo {
    const bf16_t* O; const float* W; float* H;
    DEVI void setup(int, int* c) const { c[0] = 0; }
    DEVI const float* b0(int) const { return W; } DEVI const float* b1(int) const { return nullptr; }
    DEVI int ldb() const { return D; } DEVI int K() const { return D; }
    DEVI float a(int rt, int r, int k, int, int, int) const { return bf2f(O[(size_t)(rt * 64 + r) * D + k]); }
    DEVI void epi(int rt, int r, int col, float v0, float, int, int, int) const { H[(size_t)(rt * 64 + r) * D + col] += v0; }
};

__global__ __launch_bounds__(64) void k_ssm_naive(const float* U, const float* tab, const float* c_re, const float* c_im, const float* d_skip, bf16_t* Z) {
    __shared__ float xs[64][130];
    __shared__ float us[64][16];
    __shared__ float cr[16][64], ci[16][64];
    const int bg = blockIdx.x, g = bg % SG, p = threadIdx.x;
    float bbr[SC], bbi[SC];
#pragma unroll
    for (int c = 0; c < SC; ++c) { bbr[c] = tab[TAB_BB + ((g * SP + p) * SC + c) * 2]; bbi[c] = tab[TAB_BB + ((g * SP + p) * SC + c) * 2 + 1]; }
    const float ar = tab[TAB_ABAR + (g * SP + p) * 2], ai = tab[TAB_ABAR + (g * SP + p) * 2 + 1];
    for (int i = p; i < 16 * 64; i += 64) { cr[i / 64][i % 64] = c_re[(size_t)g * 1024 + i]; ci[i / 64][i % 64] = c_im[(size_t)g * 1024 + i]; }
    float dsk[SC];
#pragma unroll
    for (int c = 0; c < SC; ++c) dsk[c] = d_skip[g * SC + c];
    float xr = 0.f, xi = 0.f;
    const float* Ub = U + (size_t)bg * S * SC;
    bf16_t* Zb = Z + (size_t)bg * S * SC;
    for (int t0 = 0; t0 < S; t0 += 64) {
        __syncthreads();
        for (int i = p; i < 64 * 16; i += 64) us[i / 16][i % 16] = Ub[(size_t)t0 * SC + i];
        __syncthreads();
        for (int t = 0; t < 64; ++t) {
            float br = 0.f, bi = 0.f;
#pragma unroll
            for (int c = 0; c < SC; ++c) { const float u = us[t][c]; br += u * bbr[c]; bi += u * bbi[c]; }
            const float nr = ar * xr - ai * xi + br, ni = ar * xi + ai * xr + bi;
            xr = nr; xi = ni; xs[t][2 * p] = xr; xs[t][2 * p + 1] = xi;
        }
        __syncthreads();
        const int t = p;
        float y[SC];
#pragma unroll
        for (int c = 0; c < SC; ++c) y[c] = 0.f;
        for (int q = 0; q < SP; ++q) { const float a = xs[t][2 * q], b = xs[t][2 * q + 1];
#pragma unroll
            for (int c = 0; c < SC; ++c) y[c] += a * cr[c][q] - b * ci[c][q]; }
#pragma unroll
        for (int c = 0; c < SC; ++c) { const float v = y[c] + dsk[c] * us[t][c]; Zb[(size_t)(t0 + t) * SC + c] = f2bf(gelu_tanh(v)); }
    }
}

__global__ __launch_bounds__(256) void k_ksum_naive(const bf16_t* Kb, float* KSUM) {
    const int bhn = blockIdx.x, bh = bhn / NBLK, n = bhn % NBLK, d = threadIdx.x;
    if (d >= HD) return;
    float s = 0.f;
    for (int j = 0; j < MBLK; ++j) s += bf2f(Kb[((size_t)bh * S + n * MBLK + j) * HD + d]);
    KSUM[(size_t)bhn * HD + d] = s;
}
__global__ __launch_bounds__(256) void k_attn_naive(const bf16_t* Q, const bf16_t* Kb, const bf16_t* Vb, const float* KSUM, bf16_t* O) {
    __shared__ float qs[4][HD];
    __shared__ float sc[4][1024];
    const int lane = threadIdx.x & 63, wid = threadIdx.x >> 6;
    const int gq = blockIdx.x * 4 + wid;
    const int bh = gq / S, s = gq % S, cur = s / MBLK;
    const bf16_t* qp = Q + (size_t)gq * HD;
    qs[wid][lane] = bf2f(qp[lane]); qs[wid][lane + 64] = bf2f(qp[lane + 64]);
    __syncthreads();
    float gate[NBLK];
#pragma unroll
    for (int n = 0; n < NBLK; ++n) {
        float t = 0.f;
        if (n < cur) t = qs[wid][lane] * KSUM[((size_t)bh * NBLK + n) * HD + lane] + qs[wid][lane + 64] * KSUM[((size_t)bh * NBLK + n) * HD + lane + 64];
        t = wave_sum(t) * (1.f / MBLK);
        gate[n] = n < cur ? t : -1e30f;
    }
    unsigned blkpack = 0; int nsel = 0;
    unsigned used = 0;
    for (int k = 0; k < TOPK; ++k) {
        int bi = -1; float bm = -3.0e38f;
#pragma unroll
        for (int n = 0; n < NBLK; ++n) if (!((used >> n) & 1u) && gate[n] > bm) { bm = gate[n]; bi = n; }
        used |= 1u << bi;
        if (bi < cur) { blkpack |= (unsigned)bi << (4 * nsel); ++nsel; }
    }
    blkpack |= (unsigned)cur << (4 * nsel); ++nsel;
    const float scale = 0.08838834764831845f;
    float mx = -3.0e38f;
    for (int i = 0; i < nsel; ++i) {
        const int n = (int)((blkpack >> (4 * i)) & 15u);
        for (int j = lane; j < MBLK; j += 64) {
            const int key = n * MBLK + j;
            const bf16_t* kp = Kb + ((size_t)bh * S + key) * HD;
            float a = 0.f;
            for (int d = 0; d < HD; d += 8) {
                const uint4 w = *(const uint4*)(kp + d);
                a += qs[wid][d] * __uint_as_float(w.x << 16) + qs[wid][d + 1] * __uint_as_float(w.x & 0xffff0000u)
                   + qs[wid][d + 2] * __uint_as_float(w.y << 16) + qs[wid][d + 3] * __uint_as_float(w.y & 0xffff0000u)
                   + qs[wid][d + 4] * __uint_as_float(w.z << 16) + qs[wid][d + 5] * __uint_as_float(w.z & 0xffff0000u)
                   + qs[wid][d + 6] * __uint_as_float(w.w << 16) + qs[wid][d + 7] * __uint_as_float(w.w & 0xffff0000u);
            }
            a *= scale;
            if (key > s) a = -1e30f;
            sc[wid][i * MBLK + j] = a;
            mx = fmaxf(mx, a);
        }
    }
    mx = wave_max(mx);
    float sum = 0.f;
    for (int j = lane; j < nsel * MBLK; j += 64) { const float pv = __expf(sc[wid][j] - mx); sc[wid][j] = pv; sum += pv; }
    sum = wave_sum(sum);
    __syncthreads();
    float o0 = 0.f, o1 = 0.f;
    for (int i = 0; i < nsel; ++i) {
        const int n = (int)((blkpack >> (4 * i)) & 15u);
        for (int j = 0; j < MBLK; ++j) {
            const float pv = sc[wid][i * MBLK + j];
            const unsigned w = *(const unsigned*)(Vb + ((size_t)bh * S + n * MBLK + j) * HD + 2 * lane);
            o0 += pv * __uint_as_float(w << 16); o1 += pv * __uint_as_float(w & 0xffff0000u);
        }
    }
    const float inv = 1.f / sum;
    const int b = bh / NH, h = bh % NH;
    const unsigned w = (unsigned)f2bf(o0 * inv) | ((unsigned)f2bf(o1 * inv) << 16);
    *(unsigned*)(O + ((size_t)b * S + s) * D + h * HD + 2 * lane) = w;
}


#define LAS __attribute__((address_space(3)))
#define GAS __attribute__((address_space(1)))
typedef short bf16x8 __attribute__((ext_vector_type(8)));
typedef float f32x4 __attribute__((ext_vector_type(4)));
typedef float f32x2 __attribute__((ext_vector_type(2)));
typedef unsigned u32x4 __attribute__((ext_vector_type(4)));
typedef unsigned u32x2 __attribute__((ext_vector_type(2)));
constexpr int NWAVES = 8, NTHR = 512;
constexpr int LDS_RING = 131072;
constexpr int LDS_TAB = LDS_RING;
constexpr int LDS_MISC = LDS_RING + 12288;
constexpr int LDS_BYTES = 147456;

DEVI unsigned cvt_pk_bf16(float lo, float hi) { unsigned r; asm volatile("v_cvt_pk_bf16_f32 %0, %1, %2" : "=v"(r) : "v"(lo), "v"(hi)); return r; }
DEVI float fast_sigmoid(float x) { return __builtin_amdgcn_rcpf(1.f + __expf(-x)); }

#define XB_TMO      128
#define XB_XCNT(j)  (256  + 64 * (j))
#define XB_XSUB(j)  (1280 + 64 * (j))
#define XB_XGEN(j)  (2304 + 64 * (j))
#define XB_TOP      3328
#define XB_TOPGEN   3392
#define XCD_BAR_WORDS 3456
#define XB_SPIN_CAP (1u << 18)
DEVI unsigned xb_ld(unsigned* p)              { return __hip_atomic_load(p, __ATOMIC_RELAXED, __HIP_MEMORY_SCOPE_AGENT); }
DEVI unsigned xb_add(unsigned* p, unsigned v) { return __hip_atomic_fetch_add(p, v, __ATOMIC_RELAXED, __HIP_MEMORY_SCOPE_AGENT); }
DEVI unsigned xb_xcc_id() { return (unsigned)__builtin_amdgcn_s_getreg((3 << 11) | 20) & 0xFu; }
#define XB_SPIN(cond, bar) do { unsigned _sp = 0; while (cond) { __builtin_amdgcn_s_sleep(1); \
    if ((++_sp & 255u) == 0u) { if (xb_ld(&(bar)[XB_TMO])) break; if (_sp > XB_SPIN_CAP) { atomicAdd(&(bar)[XB_TMO], 1u); break; } } } } while (0)
struct XcdBarrier { unsigned* bar; unsigned x; volatile LAS unsigned* st; };
DEVI XcdBarrier xcd_barrier_post(unsigned* bar, volatile LAS unsigned* st) {
    XcdBarrier b; b.bar = bar; b.x = xb_xcc_id(); b.st = st;
    if (threadIdx.x == 0) (void)xb_add(&bar[XB_XCNT(b.x)], 1u);
    return b;
}
DEVI void xcd_barrier_complete(unsigned* bar, unsigned x, unsigned& nloc, unsigned& nx) {
    const unsigned G = gridDim.x * gridDim.y * gridDim.z;
    unsigned sum, cnt, mine, sp = 0u;
    for (;;) {
        sum = 0u; cnt = 0u; mine = 0u;
#pragma unroll
        for (unsigned j = 0; j < 16; ++j) { const unsigned c = xb_ld(&bar[XB_XCNT(j)]); sum += c; cnt += (c > 0u) ? 1u : 0u; mine = (j == x) ? c : mine; }
        if (sum == G) break;
        __builtin_amdgcn_s_sleep(1);
        if ((++sp & 255u) == 0u) { if (xb_ld(&bar[XB_TMO])) break; if (sp > XB_SPIN_CAP) { atomicAdd(&bar[XB_TMO], 1u); break; } }
    }
    nloc = mine > 0u ? mine : 1u; nx = cnt > 0u ? cnt : 1u;
}
DEVI void xcd_barrier(const XcdBarrier& b) {
    asm volatile("s_waitcnt vmcnt(0)" ::: "memory");
    __syncthreads();
    if (threadIdx.x == 0) {
        unsigned* bar = b.bar;
        __builtin_amdgcn_s_waitcnt(0);
        unsigned nloc = b.st[0], nx = b.st[1];
        if (nloc == 0u) { xcd_barrier_complete(bar, b.x, nloc, nx); b.st[0] = nloc; b.st[1] = nx; }
        const unsigned old = xb_add(&bar[XB_XSUB(b.x)], 1u);
        const unsigned gen = old / nloc;
        if (old + 1u == (gen + 1u) * nloc) {
            __builtin_amdgcn_fence(__ATOMIC_RELEASE, "agent");
            asm volatile("s_waitcnt vmcnt(0)" ::: "memory");
            const unsigned og = xb_add(&bar[XB_TOP], 1u);
            const unsigned tg = og / nx;
            if (og + 1u == (tg + 1u) * nx) xb_add(&bar[XB_TOPGEN], 1u);
            else XB_SPIN(xb_ld(&bar[XB_TOPGEN]) == tg, bar);
            __builtin_amdgcn_fence(__ATOMIC_ACQUIRE, "agent");
            xb_add(&bar[XB_XGEN(b.x)], 1u);
            asm volatile("s_waitcnt vmcnt(0)" ::: "memory");
        } else {
            XB_SPIN(xb_ld(&bar[XB_XGEN(b.x)]) == gen, bar);
            __builtin_amdgcn_fence(__ATOMIC_ACQUIRE, "agent");
            asm volatile("s_waitcnt vmcnt(0)" ::: "memory");
        }
    }
    __syncthreads();
}

namespace pg8 {
constexpr int BM = 256, BK = 64, HALF = 128, HTB = HALF * BK * 2, STAGE_BYTES = 8 * HTB, NXCD = 8, WGM = 8;
__host__ __device__ __forceinline__ int lds_byte(int r, int c) { const int st = (r >> 4) * 2 + (c >> 5), rr = r & 15, cc = c & 31, ob = rr * 64 + cc * 2; return st * 1024 + (ob ^ (((ob >> 9) & 1) << 5)); }
__host__ __device__ __forceinline__ void stage_rc(int b, int& R, int& C) { const int st = b / 1024, sb = b % 1024, swz = sb ^ (((sb >> 9) & 1) << 5); R = (st >> 1) * 16 + swz / 64; C = (st & 1) * 32 + (swz % 64) / 2; }
__host__ __device__ __forceinline__ int perm32(int rho) { const int n = rho >> 4, i = rho & 15; return 8 * (i >> 2) + 4 * n + (i & 3); }
struct Unit { int pm, pn, e; };
DEVI bool static_next(int i, int nM, int nN, int G, int c, Unit& u) {
    const int nwg = nM * nN; const long L = (long)i * G + c; if (L >= nwg) return false;
    int wgid = (int)L; { const int q = nwg / NXCD, r = nwg % NXCD, xcd = wgid % NXCD, off = wgid / NXCD; wgid = (xcd < r ? xcd * (q + 1) : r * (q + 1) + (xcd - r) * q) + off; }
    const int nig = WGM * nN, gid = wgid / nig, fm = gid * WGM, gsz = (nM - fm) < WGM ? (nM - fm) : WGM;
    u.pm = fm + ((wgid % nig) % gsz); u.pn = (wgid % nig) / gsz; u.e = 0; return true;
}

template <class P>
DEVI void gemm_phase(LAS unsigned char* lds, const P& S) {
    const int tid = threadIdx.x, wid = __builtin_amdgcn_readfirstlane(tid >> 6), lane = tid & 63, wr = wid >> 2, wc = wid & 3, fr = lane & 15, fq = lane >> 4;
    const int K = S.K, nt = K / BK;
    int R[2], C[2]; unsigned voffB[2];
#pragma unroll
    for (int i = 0; i < 2; ++i) { stage_rc(tid * 16 + i * 8192, R[i], C[i]); const int Rb = P::PERM ? ((R[i] & ~31) + perm32(R[i] & 31)) : R[i]; voffB[i] = (unsigned)(Rb * K + C[i]) * 2u; }
    const size_t kstep = (size_t)(BK * 2);
    const size_t hstep = (size_t)HALF * K * 2;
    const unsigned ldsw = (unsigned)wid * 1024u;
    const int aoff = lds_byte(wr * 64 + fr, fq * 8), boff = lds_byte(wc * 32 + fr, fq * 8);
    const char* const abase = S.a_base();
#define PG8_SA(b, h) (((b) * 2 + (h)) * HTB)
#define PG8_SB(b, h) ((4 + (b) * 2 + (h)) * HTB)
#define PG8_STAGE(bufoff, gbase, voff) do { _Pragma("unroll") for (int _i = 0; _i < 2; ++_i) \
        __builtin_amdgcn_global_load_lds((const unsigned*)((const char*)(gbase) + (voff)[_i]), (LAS unsigned*)(lds + (bufoff) + ldsw + _i * 8192), 16, 0, 0); } while (0)
#define PG8_LDA(dst, b, h) do { _Pragma("unroll") for (int m = 0; m < 4; ++m) _Pragma("unroll") for (int k = 0; k < 2; ++k) dst[m][k] = *(const LAS bf16x8*)(lds + PG8_SA(b, h) + aoff + m * 2048 + k * 1024); } while (0)
#define PG8_LDB(dst, b, h) do { _Pragma("unroll") for (int n = 0; n < 2; ++n) _Pragma("unroll") for (int k = 0; k < 2; ++k) dst[n][k] = *(const LAS bf16x8*)(lds + PG8_SB(b, h) + boff + n * 2048 + k * 1024); } while (0)
#define PG8_MMA(ai, bj, At, Bt) do { __builtin_amdgcn_s_setprio(1); _Pragma("unroll") for (int m = 0; m < 4; ++m) _Pragma("unroll") for (int n = 0; n < 2; ++n) _Pragma("unroll") for (int k = 0; k < 2; ++k) \
        acc[ai][bj][m][n] = __builtin_amdgcn_mfma_f32_16x16x32_bf16(Bt[n][k], At[m][k], acc[ai][bj][m][n], 0, 0, 0); __builtin_amdgcn_s_setprio(0); } while (0)
#define PG8_WAIT_V(n) asm volatile("s_waitcnt vmcnt(" #n ")" ::: "memory")
#define PG8_WAIT_L(n) asm volatile("s_waitcnt lgkmcnt(" #n ")" ::: "memory")
#define PG8_BAR __builtin_amdgcn_s_barrier()
#define PG8_SCHED __builtin_amdgcn_sched_barrier(0)
    Unit cur, nxt; int ui = 0;
    if (!S.next(0, cur)) return;
    f32x4 acc[2][2][4][2];
#pragma unroll
    for (int a = 0; a < 2; ++a)
#pragma unroll
        for (int b = 0; b < 2; ++b)
#pragma unroll
            for (int m = 0; m < 4; ++m)
#pragma unroll
                for (int n = 0; n < 2; ++n) acc[a][b][m][n] = (f32x4){0.f, 0.f, 0.f, 0.f};
    bf16x8 At[4][2], B0[2][2], B1[2][2];
    unsigned oc0[2], oc1[2], on0[2], on1[2];
    S.a_off(cur, 0, R, C, oc0); S.a_off(cur, 1, R, C, oc1);
    const char* cB = S.b_base(cur);
    {
        const char* a0 = abase; const char* a1 = abase + P::KSTEP_A;
        PG8_STAGE(PG8_SB(0, 0), cB, voffB); PG8_STAGE(PG8_SB(0, 1), cB + hstep, voffB); PG8_STAGE(PG8_SA(0, 0), a0, oc0); PG8_STAGE(PG8_SA(0, 1), a0, oc1);
        if (wr == 1) PG8_BAR;
        PG8_WAIT_V(2); PG8_BAR;
        PG8_STAGE(PG8_SB(1, 0), cB + kstep, voffB); PG8_STAGE(PG8_SA(1, 0), a1, oc0); PG8_STAGE(PG8_SB(1, 1), cB + hstep + kstep, voffB);
        PG8_WAIT_V(6); PG8_BAR;
    }
    for (;;) {
        const bool has_next = S.next(ui + 1, nxt);
        if (has_next) { S.a_off(nxt, 0, R, C, on0); S.a_off(nxt, 1, R, C, on1); }
        else { on0[0] = oc0[0]; on0[1] = oc0[1]; on1[0] = oc1[0]; on1[1] = oc1[1]; }
        const char* nB = has_next ? S.b_base(nxt) : cB;
#pragma nounroll
        for (int t = 0; t < nt; t += 2) {
            const bool last = (t == nt - 2);
            const char* a1 = abase + (size_t)(t + 1) * P::KSTEP_A;
            const char* a2 = last ? abase : abase + (size_t)(t + 2) * P::KSTEP_A; const char* b2 = last ? nB : cB + (size_t)(t + 2) * kstep;
            const char* a3 = a2 + P::KSTEP_A; const char* b3 = b2 + kstep;
            unsigned o20[2], o21[2];
            o20[0] = last ? on0[0] : oc0[0]; o20[1] = last ? on0[1] : oc0[1]; o21[0] = last ? on1[0] : oc1[0]; o21[1] = last ? on1[1] : oc1[1];
            PG8_LDB(B0, 0, 0); PG8_LDB(B1, 0, 1); PG8_SCHED; PG8_LDA(At, 0, 0); PG8_STAGE(PG8_SA(1, 1), a1, oc1);
            PG8_WAIT_V(8); PG8_WAIT_L(0); PG8_BAR; PG8_MMA(0, 0, At, B0); PG8_MMA(0, 1, At, B1); PG8_BAR; PG8_SCHED;
            PG8_LDA(At, 0, 1); PG8_STAGE(PG8_SB(0, 0), b2, voffB); PG8_STAGE(PG8_SB(0, 1), b2 + hstep, voffB); PG8_STAGE(PG8_SA(0, 0), a2, o20);
            PG8_WAIT_V(8); PG8_WAIT_L(0); PG8_BAR; PG8_MMA(1, 0, At, B0); PG8_MMA(1, 1, At, B1); PG8_BAR; PG8_SCHED;
            PG8_LDB(B0, 1, 0); PG8_LDB(B1, 1, 1); PG8_SCHED; PG8_LDA(At, 1, 0); PG8_STAGE(PG8_SA(0, 1), a2, o21);
            PG8_WAIT_V(8); PG8_WAIT_L(0); PG8_BAR; PG8_MMA(0, 0, At, B0); PG8_MMA(0, 1, At, B1); PG8_BAR; PG8_SCHED;
            PG8_LDA(At, 1, 1); PG8_STAGE(PG8_SB(1, 0), b3, voffB); PG8_STAGE(PG8_SB(1, 1), b3 + hstep, voffB); PG8_STAGE(PG8_SA(1, 0), a3, o20);
            PG8_WAIT_V(8); PG8_WAIT_L(0); PG8_BAR; PG8_MMA(1, 0, At, B0); PG8_MMA(1, 1, At, B1); PG8_BAR; PG8_SCHED;
        }
        if (wr == 0) PG8_BAR;
        S.epi(acc, cur, wr, wc, fr, fq);
        if (!has_next) break;
#pragma unroll
        for (int a = 0; a < 2; ++a)
#pragma unroll
            for (int b = 0; b < 2; ++b)
#pragma unroll
                for (int m = 0; m < 4; ++m)
#pragma unroll
                    for (int n = 0; n < 2; ++n) acc[a][b][m][n] = (f32x4){0.f, 0.f, 0.f, 0.f};
        cur = nxt; cB = nB; ++ui;
        oc0[0] = on0[0]; oc0[1] = on0[1]; oc1[0] = on1[0]; oc1[1] = on1[1];
        if (wr == 1) PG8_BAR;
    }
    PG8_WAIT_V(0);
    PG8_BAR;
#undef PG8_SA
#undef PG8_SB
#undef PG8_STAGE
#undef PG8_LDA
#undef PG8_LDB
#undef PG8_MMA
#undef PG8_WAIT_V
#undef PG8_WAIT_L
#undef PG8_BAR
#undef PG8_SCHED
}
}
using pg8::Unit;

struct PWin {
    static constexpr bool PERM = false; static constexpr unsigned KSTEP_A = 128;
    const bf16_t* A; const bf16_t* Bt; float* U; int K, G, c;
    DEVI const char* a_base() const { return (const char*)A; }
    DEVI bool next(int i, Unit& u) const { return pg8::static_next(i, NTOK / 256, D / 256, G, c, u); }
    DEVI void a_off(const Unit& u, int h, const int (&R)[2], const int (&C)[2], unsigned (&o)[2]) const {
#pragma unroll
        for (int i = 0; i < 2; ++i) o[i] = (unsigned)((u.pm * 256 + h * 128 + R[i]) * D + C[i]) * 2u; }
    DEVI const char* b_base(const Unit& u) const { return (const char*)(Bt + (size_t)u.pn * 256 * D); }
    DEVI void epi(const f32x4 (&acc)[2][2][4][2], const Unit& u, int wr, int wc, int fr, int fq) const {
#pragma unroll
        for (int ai = 0; ai < 2; ++ai)
#pragma unroll
            for (int m = 0; m < 4; ++m) { const int row = u.pm * 256 + wr * 64 + fr + ai * 128 + m * 16, b = row >> 12, t = row & (S - 1);
#pragma unroll
                for (int bj = 0; bj < 2; ++bj)
#pragma unroll
                    for (int n = 0; n < 2; ++n) { const int g = u.pn * 16 + bj * 8 + wc * 2 + n;
                        *(f32x4*)(U + (((size_t)b * SG + g) * S + t) * SC + 4 * fq) = acc[ai][bj][m][n]; } }
    }
};
struct PWout {
    static constexpr bool PERM = false; static constexpr unsigned KSTEP_A = 4u * S * SC * 2u;
    const bf16_t* A; const bf16_t* Bt; const float* X; float* H; int K, G, c;
    DEVI const char* a_base() const { return (const char*)A; }
    DEVI bool next(int i, Unit& u) const { return pg8::static_next(i, NTOK / 256, 8, G, c, u); }
    DEVI void a_off(const Unit& u, int h, const int (&R)[2], const int (&C)[2], unsigned (&o)[2]) const {
#pragma unroll
        for (int i = 0; i < 2; ++i) { const int row = u.pm * 256 + h * 128 + R[i], b = row >> 12, t = row & (S - 1);
            o[i] = (unsigned)(b * SG * S + t) * 32u + (unsigned)(C[i] >> 4) * (unsigned)(S * SC * 2) + (unsigned)(C[i] & 15) * 2u; } }
    DEVI const char* b_base(const Unit& u) const { return (const char*)(Bt + (size_t)u.pn * 256 * D); }
    DEVI void epi(const f32x4 (&acc)[2][2][4][2], const Unit& u, int wr, int wc, int fr, int fq) const {
#pragma unroll
        for (int ai = 0; ai < 2; ++ai)
#pragma unroll
            for (int m = 0; m < 4; ++m) { const int row = u.pm * 256 + wr * 64 + fr + ai * 128 + m * 16;
#pragma unroll
                for (int n = 0; n < 2; ++n) { const size_t o = (size_t)row * D + u.pn * 128 + wc * 32 + n * 16 + 4 * fq;
                    const f32x4 xv = *(const f32x4*)(X + o); const f32x4 v = acc[ai][0][m][n], g = acc[ai][1][m][n]; f32x4 r;
#pragma unroll
                    for (int j = 0; j < 4; ++j) r[j] = xv[j] + v[j] * fast_sigmoid(g[j]);
                    *(f32x4*)(H + o) = r; } }
    }
};
struct PQkv {
    static constexpr bool PERM = true; static constexpr unsigned KSTEP_A = 128;
    const bf16_t* A; const bf16_t* Bt; bf16_t* Q; float* KSUM; int K, G, c;
    DEVI const char* a_base() const { return (const char*)A; }
    DEVI bool next(int i, Unit& u) const { return pg8::static_next(i, NTOK / 256, 12, G, c, u); }
    DEVI void a_off(const Unit& u, int h, const int (&R)[2], const int (&C)[2], unsigned (&o)[2]) const {
#pragma unroll
        for (int i = 0; i < 2; ++i) o[i] = (unsigned)((u.pm * 256 + h * 128 + R[i]) * D + C[i]) * 2u; }
    DEVI const char* b_base(const Unit& u) const { return (const char*)(Bt + (size_t)u.pn * 256 * D); }
    DEVI void epi(const f32x4 (&acc)[2][2][4][2], const Unit& u, int wr, int wc, int fr, int fq) const {
        const int which = u.pn >> 2, b = u.pm >> 4, nb = u.pm & 15;
        bf16_t* base = Q + (size_t)which * ((size_t)NTOK * D);
#pragma unroll
        for (int ai = 0; ai < 2; ++ai)
#pragma unroll
            for (int m = 0; m < 4; ++m) { const int t = nb * 256 + wr * 64 + fr + ai * 128 + m * 16;
#pragma unroll
                for (int bj = 0; bj < 2; ++bj) { const int h = (u.pn & 3) * 2 + bj; const f32x4 v0 = acc[ai][bj][m][0], v1 = acc[ai][bj][m][1];
                    u32x4 w; w.x = cvt_pk_bf16(v0[0], v0[1]); w.y = cvt_pk_bf16(v0[2], v0[3]); w.z = cvt_pk_bf16(v1[0], v1[1]); w.w = cvt_pk_bf16(v1[2], v1[3]);
                    *(u32x4*)(base + (((size_t)b * NH + h) * S + t) * HD + wc * 32 + 8 * fq) = w; } }
        if (which == 1) {
#pragma unroll
            for (int bj = 0; bj < 2; ++bj) { const int h = (u.pn & 3) * 2 + bj;
#pragma unroll
                for (int n = 0; n < 2; ++n)
#pragma unroll
                    for (int j = 0; j < 4; ++j) { float s = 0.f;
#pragma unroll
                        for (int ai = 0; ai < 2; ++ai)
#pragma unroll
                            for (int m = 0; m < 4; ++m) s += acc[ai][bj][m][n][j];
                        s += __shfl_xor(s, 1); s += __shfl_xor(s, 2); s += __shfl_xor(s, 4); s += __shfl_xor(s, 8);
                        if (fr == 0) atomicAdd(KSUM + (((size_t)b * NH + h) * NBLK + nb) * HD + wc * 32 + 8 * fq + 4 * n + j, s); } }
        }
    }
};
struct PWo {
    static constexpr bool PERM = false; static constexpr unsigned KSTEP_A = 128;
    const bf16_t* A; const bf16_t* Bt; float* H; int K, G, c;
    DEVI const char* a_base() const { return (const char*)A; }
    DEVI bool next(int i, Unit& u) const { return pg8::static_next(i, NTOK / 256, D / 256, G, c, u); }
    DEVI void a_off(const Unit& u, int h, const int (&R)[2], const int (&C)[2], unsigned (&o)[2]) const {
#pragma unroll
        for (int i = 0; i < 2; ++i) o[i] = (unsigned)((u.pm * 256 + h * 128 + R[i]) * D + C[i]) * 2u; }
    DEVI const char* b_base(const Unit& u) const { return (const char*)(Bt + (size_t)u.pn * 256 * D); }
    DEVI void epi(const f32x4 (&acc)[2][2][4][2], const Unit& u, int wr, int wc, int fr, int fq) const {
#pragma unroll
        for (int ai = 0; ai < 2; ++ai)
#pragma unroll
            for (int m = 0; m < 4; ++m) { const int row = u.pm * 256 + wr * 64 + fr + ai * 128 + m * 16;
#pragma unroll
                for (int bj = 0; bj < 2; ++bj)
#pragma unroll
                    for (int n = 0; n < 2; ++n) { float* p = H + (size_t)row * D + u.pn * 256 + bj * 128 + wc * 32 + n * 16 + 4 * fq;
                        *(f32x4*)p = *(const f32x4*)p + acc[ai][bj][m][n]; } }
    }
};
constexpr int MOE_MAXU = 4;
DEVI bool moe_next(const volatile LAS int* tabI, int i, int G, int c, Unit& u) {
    const int L = i * G + c, T = tabI[64]; if (L >= T * 4) return false;
    u.pm = L >> 2; u.pn = L & 3; int e = 0;
#pragma unroll 1
    for (int j = 1; j < NE; ++j) if (tabI[32 + j] <= u.pm * 256) e = j; else break;
    u.e = e; return true;
}
DEVI void moe_plan(LAS int* tabI, const unsigned* cnt, const int* row_token, int G, int c, bool want_tok) {
    const int tid = threadIdx.x;
    if (tid < 64) {
        int n = tid < NE ? (int)__hip_atomic_load(cnt + (tid & 31), __ATOMIC_RELAXED, __HIP_MEMORY_SCOPE_AGENT) : 0; if (tid >= NE) n = 0;
        const int pc = (n + 255) & ~255; int incl = pc;
#pragma unroll
        for (int o = 1; o < 32; o <<= 1) { const int t = __shfl_up(incl, o); if ((tid & 31) >= o) incl += t; }
        if (tid < NE) { tabI[tid] = n; tabI[32 + tid] = incl - pc; }
        if (tid == NE - 1) tabI[64] = incl >> 8;
    }
    __syncthreads();
    if (want_tok) {
        for (int ui = 0; ui < MOE_MAXU; ++ui) { Unit u; if (!moe_next(tabI, ui, G, c, u)) break;
            const int n = tabI[u.e], base = tabI[32 + u.e];
            for (int r = tid; r < 256; r += NTHR) { const int pos = u.pm * 256 + r - base; tabI[128 + 256 * ui + r] = pos < n ? row_token[u.e * ECAP + pos] : 0; } }
    }
    asm volatile("s_waitcnt vmcnt(0) lgkmcnt(0)" ::: "memory");
    __syncthreads();
}
struct PMoe1 {
    static constexpr bool PERM = true; static constexpr unsigned KSTEP_A = 128;
    const bf16_t* A; const bf16_t* Bt; bf16_t* ACT; const volatile LAS int* tabI; int K, G, c;
    DEVI const char* a_base() const { return (const char*)A; }
    DEVI bool next(int i, Unit& u) const { const bool ok = moe_next(tabI, i, G, c, u); u.e |= i << 8; return ok; }
    DEVI void a_off(const Unit& u, int h, const int (&R)[2], const int (&C)[2], unsigned (&o)[2]) const {
#pragma unroll
        for (int i = 0; i < 2; ++i) { const int tok = tabI[128 + 256 * (u.e >> 8) + h * 128 + R[i]]; o[i] = (unsigned)(tok * D + C[i]) * 2u; } }
    DEVI const char* b_base(const Unit& u) const { return (const char*)(Bt + ((size_t)(u.e & 255) * 1024 + (size_t)u.pn * 256) * D); }
    DEVI void epi(const f32x4 (&acc)[2][2][4][2], const Unit& u, int wr, int wc, int fr, int fq) const {
#pragma unroll
        for (int ai = 0; ai < 2; ++ai)
#pragma unroll
            for (int m = 0; m < 4; ++m) { const int row = u.pm * 256 + wr * 64 + fr + ai * 128 + m * 16; float r[8];
#pragma unroll
                for (int n = 0; n < 2; ++n)
#pragma unroll
                    for (int j = 0; j < 4; ++j) { const float a = acc[ai][0][m][n][j], b = acc[ai][1][m][n][j]; r[4 * n + j] = a * fast_sigmoid(a) * b; }
                u32x4 w; w.x = cvt_pk_bf16(r[0], r[1]); w.y = cvt_pk_bf16(r[2], r[3]); w.z = cvt_pk_bf16(r[4], r[5]); w.w = cvt_pk_bf16(r[6], r[7]);
                *(u32x4*)(ACT + (size_t)row * FF + u.pn * 128 + wc * 32 + 8 * fq) = w; }
    }
};
struct PMoe2 {
    static constexpr bool PERM = true; static constexpr unsigned KSTEP_A = 128;
    const bf16_t* A; const bf16_t* Bt; bf16_t* Y; const volatile LAS int* tabI; int K, G, c;
    DEVI const char* a_base() const { return (const char*)A; }
    DEVI bool next(int i, Unit& u) const { return moe_next(tabI, i, G, c, u); }
    DEVI void a_off(const Unit& u, int h, const int (&R)[2], const int (&C)[2], unsigned (&o)[2]) const {
#pragma unroll
        for (int i = 0; i < 2; ++i) o[i] = (unsigned)((u.pm * 256 + h * 128 + R[i]) * FF + C[i]) * 2u; }
    DEVI const char* b_base(const Unit& u) const { return (const char*)(Bt + ((size_t)u.e * 1024 + (size_t)u.pn * 256) * FF); }
    DEVI void epi(const f32x4 (&acc)[2][2][4][2], const Unit& u, int wr, int wc, int fr, int fq) const {
#pragma unroll
        for (int ai = 0; ai < 2; ++ai)
#pragma unroll
            for (int m = 0; m < 4; ++m) { const int row = u.pm * 256 + wr * 64 + fr + ai * 128 + m * 16;
#pragma unroll
                for (int bj = 0; bj < 2; ++bj) { const f32x4 v0 = acc[ai][bj][m][0], v1 = acc[ai][bj][m][1];
                    u32x4 w; w.x = cvt_pk_bf16(v0[0], v0[1]); w.y = cvt_pk_bf16(v0[2], v0[3]); w.z = cvt_pk_bf16(v1[0], v1[1]); w.w = cvt_pk_bf16(v1[2], v1[3]);
                    *(u32x4*)(Y + (size_t)row * D + u.pn * 256 + bj * 128 + wc * 32 + 8 * fq) = w; } }
    }
};


namespace attn {
typedef short s16x4 __attribute__((ext_vector_type(4)));
typedef float f32x16 __attribute__((ext_vector_type(16)));
constexpr float SCALE = 0.08838834764831845f;
constexpr float THR = 8.f;
constexpr int NW = 8, QBLK = 32, KVBLK = 64, QB = NW * QBLK, DH = 128;
constexpr int SHM_V = KVBLK * DH * 2, SHM_K = KVBLK * DH * 2;
constexpr int ATT_LDS = 2 * SHM_V + 2 * SHM_K + NW * 64 * 4;
#define KSWZ(row, colB) ((row) * 256 + ((colB) ^ (((row) & 7) << 4)))
#define SBAR() __builtin_amdgcn_sched_barrier(0)
DEVI int v_st(int k, int c) { const int kk = (k & ~0xC) | ((k & 4) << 1) | ((k & 8) >> 1); return ((kk >> 3) * 4 + (c >> 5)) * 512 + ((kk & 7) * 32 + (c & 31)) * 2; }
DEVI int v_rd_base(int lane) { return ((lane & 3) << 3) | (((lane >> 2) & 3) << 6) | (((lane >> 4) & 1) << 5) | (((lane >> 5) & 1) << 8); }
constexpr int v_rd_off(int d0, int ks, int half) { return d0 * 512 + ks * 4096 + half * 2048; }
DEVI int crow(int r, int hi) { return (r & 3) + 8 * (r >> 2) + 4 * hi; }
DEVI unsigned cvtpk(float lo, float hi) { unsigned r; asm volatile("v_cvt_pk_bf16_f32 %0, %1, %2" : "=v"(r) : "v"(lo), "v"(hi)); return r; }
DEVI bf16x8 load8(const bf16_t* p) { return *reinterpret_cast<const bf16x8*>(p); }
DEVI void mask_tile(f32x16& p0, f32x16& p1, int dq) {
    const float NEG = -__builtin_inff();
#pragma unroll
    for (int r = 0; r < 16; ++r) {
        const int c = (r & 3) + 8 * (r >> 2);
        if (dq - c < 0) p0[r] = NEG;
        if (dq - c - 32 < 0) p1[r] = NEG;
    }
}
DEVI void partialSM(f32x16& p0, f32x16& p1, float& m_reg, float& mn, float& alpha) {
    float pmax = p0[0]; for (int r = 1; r < 16; ++r) pmax = fmaxf(pmax, p0[r]); for (int r = 0; r < 16; ++r) pmax = fmaxf(pmax, p1[r]);
    { auto rr = __builtin_amdgcn_permlane32_swap(__float_as_uint(pmax), __float_as_uint(pmax), false, false);
      pmax = fmaxf(__uint_as_float(rr[0]), __uint_as_float(rr[1])); }
    constexpr float C2 = 1.4426950408889634f * SCALE;
    if (__builtin_expect(__all((pmax - m_reg) * SCALE <= THR), 1)) { mn = m_reg; alpha = 1.f; }
    else { mn = fmaxf(m_reg, pmax); alpha = __builtin_amdgcn_exp2f((m_reg - mn) * C2); m_reg = mn; }
    const float mnL = -mn * C2;
    for (int r = 0; r < 16; ++r) p0[r] = fmaf(p0[r], C2, mnL); for (int r = 0; r < 16; ++r) p1[r] = fmaf(p1[r], C2, mnL);
    for (int r = 0; r < 16; ++r) p0[r] = __builtin_amdgcn_exp2f(p0[r]);
}
DEVI void finishSM(f32x16& p0, f32x16& p1, float alpha, float& l_reg, bf16x8& pa0, bf16x8& pa1, bf16x8& pa2, bf16x8& pa3) {
    for (int r = 0; r < 16; ++r) p1[r] = __builtin_amdgcn_exp2f(p1[r]);
    float ps = 0; for (int r = 0; r < 16; ++r) ps += p0[r]; for (int r = 0; r < 16; ++r) ps += p1[r];
    { auto rr = __builtin_amdgcn_permlane32_swap(__float_as_uint(ps), __float_as_uint(ps), false, false);
      ps = __uint_as_float(rr[0]) + __uint_as_float(rr[1]); }
    l_reg = l_reg * alpha + ps;
#define PK4(P, B_, OUT) do { unsigned a0 = cvtpk(P[B_+0], P[B_+1]), a1 = cvtpk(P[B_+2], P[B_+3]);                          \
        unsigned b0 = cvtpk(P[B_+4], P[B_+5]), b1 = cvtpk(P[B_+6], P[B_+7]);                                             \
        auto r0 = __builtin_amdgcn_permlane32_swap(a0, b0, false, false); auto r1 = __builtin_amdgcn_permlane32_swap(a1, b1, false, false); \
        u32x4 w = {r0[0], r1[0], r0[1], r1[1]}; OUT = *reinterpret_cast<bf16x8*>(&w); } while (0)
    PK4(p0, 0, pa0); PK4(p0, 8, pa1); PK4(p1, 0, pa2); PK4(p1, 8, pa3);
#undef PK4
}
template <int KB>
DEVI void qkt(f32x16& p0, f32x16& p1, const char* K_lds, int r32, int hi, const bf16x8* qr, float bias) {
#pragma unroll
    for (int r = 0; r < 16; ++r) { p0[r] = bias; p1[r] = bias; }
    const char* kb[4];
#pragma unroll
    for (int dd = 0; dd < 4; ++dd) kb[dd] = K_lds + KB * SHM_K + KSWZ(r32, (dd * 16 + hi * 8) * 2);
#pragma unroll
    for (int d0 = 0; d0 < 8; ++d0) { const char* a = kb[d0 & 3] + (d0 >> 2) * 128;
        bf16x8 b0 = *reinterpret_cast<const bf16x8*>(a);
        bf16x8 b1 = *reinterpret_cast<const bf16x8*>(a + 32 * 256);
        p0 = __builtin_amdgcn_mfma_f32_32x32x16_bf16(b0, qr[d0], p0, 0, 0, 0);
        p1 = __builtin_amdgcn_mfma_f32_32x32x16_bf16(b1, qr[d0], p1, 0, 0, 0); }
}
template <int VB>
DEVI void pv_tile(f32x16* o, int vb0, bf16x8 pa0, bf16x8 pa1, bf16x8 pa2, bf16x8 pa3) {
#define TRRD(dst, off) asm volatile("ds_read_b64_tr_b16 %0, %1 offset:%2" : "=&v"(dst) : "v"(vb0), "i"(off) : "memory")
#define PV_D0(d0) do { s16x4 l0, l1, l2, l3, h0, h1, h2, h3; constexpr int b_ = VB * SHM_V + v_rd_off(d0, 0, 0); \
        TRRD(l0, b_); TRRD(h0, b_ + 2048); TRRD(l1, b_ + 4096); TRRD(h1, b_ + 6144); TRRD(l2, b_ + 8192); TRRD(h2, b_ + 10240); TRRD(l3, b_ + 12288); TRRD(h3, b_ + 14336); \
        asm volatile("s_waitcnt lgkmcnt(0)" ::: "memory"); SBAR();   \
        o[d0] = __builtin_amdgcn_mfma_f32_32x32x16_bf16(pa0, (bf16x8){l0[0], l0[1], l0[2], l0[3], h0[0], h0[1], h0[2], h0[3]}, o[d0], 0, 0, 0);   \
        o[d0] = __builtin_amdgcn_mfma_f32_32x32x16_bf16(pa1, (bf16x8){l1[0], l1[1], l1[2], l1[3], h1[0], h1[1], h1[2], h1[3]}, o[d0], 0, 0, 0);   \
        o[d0] = __builtin_amdgcn_mfma_f32_32x32x16_bf16(pa2, (bf16x8){l2[0], l2[1], l2[2], l2[3], h2[0], h2[1], h2[2], h2[3]}, o[d0], 0, 0, 0);   \
        o[d0] = __builtin_amdgcn_mfma_f32_32x32x16_bf16(pa3, (bf16x8){l3[0], l3[1], l3[2], l3[3], h3[0], h3[1], h3[2], h3[3]}, o[d0], 0, 0, 0); } while (0)
    PV_D0(0); PV_D0(1); PV_D0(2); PV_D0(3);
#undef PV_D0
#undef TRRD
}
struct BlockRef { const bf16_t* Q; const bf16_t* K; const bf16_t* V; bf16_t* O; const float* ks; int qb; };
struct Seam { bf16x8 qr[8]; bf16x8 st_v0, st_v1, st_k0, st_k1; };
#define ROW(p, k0, rr) ((p) + (size_t)((k0) + (rr)) * DH + sc)
#define VMW() asm volatile("s_waitcnt vmcnt(0)" ::: "memory")
#define VMWN(n) asm volatile("s_waitcnt vmcnt(%0)" :: "i"(n) : "memory")
#define SLOAD_H(Kp, Vp, k0) do { S.st_v0 = load8(ROW(Vp, k0, sr)); S.st_v1 = load8(ROW(Vp, k0, 32 + sr));              \
                         S.st_k0 = load8(ROW(Kp, k0, sr)); S.st_k1 = load8(ROW(Kp, k0, 32 + sr)); } while (0)
#define SWRITE_HK(bf) do { *(bf16x8*)(K_lds + (bf) * SHM_K + kws) = S.st_k0; *(bf16x8*)(K_lds + (bf) * SHM_K + kws + 32 * 256) = S.st_k1; } while (0)
#define SWRITE_HV(bf) do { *(bf16x8*)(V_lds + (bf) * SHM_V + vst0) = S.st_v0; *(bf16x8*)(V_lds + (bf) * SHM_V + vst1) = S.st_v1; } while (0)
#define SWRITE_H(bf) do { SWRITE_HV(bf); SWRITE_HK(bf); } while (0)
DEVI void prime(const BlockRef& cur, char* lds, Seam& S) {
    const int tid = threadIdx.x, wid = __builtin_amdgcn_readfirstlane(tid >> 6), lane = tid & 63, r32 = lane & 31, hi = lane >> 5;
    const int sr = tid >> 4, sc = (tid & 15) * 8, kws = KSWZ(sr, sc * 2); char* K_lds = lds + 2 * SHM_V;
    for (int d0 = 0; d0 < 8; ++d0) S.qr[d0] = load8(cur.Q + (size_t)(cur.qb * QB + wid * QBLK + r32) * DH + d0 * 16 + hi * 8);
    SLOAD_H(cur.K, cur.V, 0); VMW(); SWRITE_HK(0);
    __syncthreads();
}
DEVI void block(const BlockRef& cur, const BlockRef& nxt, char* lds, Seam& S) {
    const int tid = threadIdx.x, wid = __builtin_amdgcn_readfirstlane(tid >> 6), lane = tid & 63, r32 = lane & 31, hi = lane >> 5;
    const int P0 = cur.qb * QB;
    const int NT = (cur.qb + 1) * 4;
    const int qlo = P0 + wid * QBLK, qm = qlo + r32 - 4 * hi;
    char* V_lds = lds; char* K_lds = lds + 2 * SHM_V;
    float* ws = (float*)(lds + 2 * SHM_V + 2 * SHM_K) + wid * 64; float* li_l = ws, * al_l = ws + 32;
    float m_reg = -1e30f, l_reg = 0; f32x16 o[4] = {};
    const int sr = tid >> 4, sc = (tid & 15) * 8, vst0 = v_st(sr, sc), vst1 = v_st(32 + sr, sc), kws = KSWZ(sr, sc * 2);
    const int vb0 = (int)(uintptr_t)V_lds + v_rd_base(lane);
    const bf16_t* Kh = cur.K; const bf16_t* Vh = cur.V;
    unsigned selbits = 1u << cur.qb;
    {
        float v0 = -__builtin_inff(), v1 = v0, v2 = v0; int i0 = 31, i1 = 31, i2 = 31;
        for (int n = 0; n < cur.qb; ++n) {
            const float* kp = cur.ks + n * DH + hi * 8; float g = 0.f;
#pragma unroll
            for (int d0 = 0; d0 < 8; ++d0) { const f32x4 k0 = *(const f32x4*)(kp + d0 * 16), k1 = *(const f32x4*)(kp + d0 * 16 + 4); const bf16x8 q = S.qr[d0];
                g += __uint_as_float(((unsigned)(unsigned short)q[0]) << 16) * k0[0] + __uint_as_float(((unsigned)(unsigned short)q[1]) << 16) * k0[1]
                   + __uint_as_float(((unsigned)(unsigned short)q[2]) << 16) * k0[2] + __uint_as_float(((unsigned)(unsigned short)q[3]) << 16) * k0[3]
                   + __uint_as_float(((unsigned)(unsigned short)q[4]) << 16) * k1[0] + __uint_as_float(((unsigned)(unsigned short)q[5]) << 16) * k1[1]
                   + __uint_as_float(((unsigned)(unsigned short)q[6]) << 16) * k1[2] + __uint_as_float(((unsigned)(unsigned short)q[7]) << 16) * k1[3]; }
            g += __shfl_xor(g, 32);
            if (g > v0) { v2 = v1; i2 = i1; v1 = v0; i1 = i0; v0 = g; i0 = n; }
            else if (g > v1) { v2 = v1; i2 = i1; v1 = g; i1 = n; }
            else if (g > v2) { v2 = g; i2 = n; }
        }
        selbits |= (i0 < 31 ? 1u << i0 : 0u) | (i1 < 31 ? 1u << i1 : 0u) | (i2 < 31 ? 1u << i2 : 0u);
    }
#define BIAS(t) (((selbits >> ((t) >> 2)) & 1u) ? 0.f : -__builtin_inff())
#define RESC(a) do { if (__any((a) < 1.f)) { if (hi == 0) al_l[r32] = (a); asm volatile("s_waitcnt lgkmcnt(0)" ::: "memory");              \
                     for (int d_ = 0; d_ < 4; ++d_) for (int r = 0; r < 16; ++r) o[d_][r] *= al_l[crow(r, hi)]; } } while (0)
#define KBASE(t) ((t) * KVBLK)
#define MASKT(P0_, P1_, t) do { const int kb_ = KBASE(t); if (kb_ + KVBLK - 1 > qlo) mask_tile(P0_, P1_, qm - kb_); } while (0)
    constexpr int NQL = 8;
#define SEAM_K0() do { VMWN(NQL); SWRITE_HK(0); SBAR(); } while (0)
    f32x16 pA0, pA1, pB0, pB1; float mnA, mnB, alA, alB; bf16x8 pa0, pa1, pa2, pa3;
    SWRITE_HV(0); SBAR();
    if (NT > 1) { SLOAD_H(Kh, Vh, KBASE(1)); }
    SBAR(); qkt<0>(pA0, pA1, K_lds, r32, hi, S.qr, BIAS(0));
    MASKT(pA0, pA1, 0); partialSM(pA0, pA1, m_reg, mnA, alA);
    if (NT > 1) { VMW(); SWRITE_H(1); }
    __syncthreads();
#define HALF_STEP(PX0, PX1, mnX, alX, PY0, PY1, alY, t, KB, VB, SB) do {                                                      \
        SBAR(); qkt<KB>(PX0, PX1, K_lds, r32, hi, S.qr, BIAS(t));                                                \
        finishSM(PY0, PY1, alY, l_reg, pa0, pa1, pa2, pa3); SBAR();                                                           \
        if ((t) + 1 < NT) { SLOAD_H(Kh, Vh, KBASE((t) + 1)); SBAR(); }                                                        \
        pv_tile<VB>(o, vb0, pa0, pa1, pa2, pa3); MASKT(PX0, PX1, (t)); partialSM(PX0, PX1, m_reg, mnX, alX);                  \
        __syncthreads();                                                                                                      \
        if ((t) + 1 < NT) { VMW(); SWRITE_H(SB); }                                                                            \
        RESC(alX); __syncthreads(); } while (0)
    for (int t = 1; t + 1 < NT; t += 2) {
        HALF_STEP(pB0, pB1, mnB, alB, pA0, pA1, alA, t, 1, 0, 0);
        HALF_STEP(pA0, pA1, mnA, alA, pB0, pB1, alB, t + 1, 0, 1, 1);
    }
    { SBAR(); qkt<1>(pB0, pB1, K_lds, r32, hi, S.qr, 0.f); SBAR(); }
    SLOAD_H(nxt.K, nxt.V, 0); SBAR();
#pragma unroll
    for (int d0 = 0; d0 < 8; ++d0) S.qr[d0] = load8(nxt.Q + (size_t)(nxt.qb * QB + wid * QBLK + r32) * DH + d0 * 16 + hi * 8);
    SBAR();
    finishSM(pA0, pA1, alA, l_reg, pa0, pa1, pa2, pa3); SBAR();
    pv_tile<0>(o, vb0, pa0, pa1, pa2, pa3);
    { MASKT(pB0, pB1, NT - 1); partialSM(pB0, pB1, m_reg, mnB, alB); __syncthreads(); RESC(alB);
      finishSM(pB0, pB1, alB, l_reg, pa0, pa1, pa2, pa3); SBAR(); pv_tile<1>(o, vb0, pa0, pa1, pa2, pa3); }
    SBAR(); SEAM_K0();
    if (hi == 0) li_l[r32] = l_reg; asm volatile("s_waitcnt lgkmcnt(0)" ::: "memory");
    float rli[16];
#pragma unroll
    for (int r = 0; r < 16; ++r) rli[r] = __builtin_amdgcn_rcpf(li_l[crow(r, hi)]);
    bf16_t* Ow = cur.O + (size_t)(P0 + wid * QBLK) * D;
#pragma unroll
    for (int r = 0; r < 16; ++r) { const int orow = crow(r, hi);
#pragma unroll
        for (int d0 = 0; d0 < 4; ++d0) { const float v = o[d0][r] * rli[r];
            const float vn = __shfl_xor(v, 1);
            if ((r32 & 1) == 0) *(unsigned*)(Ow + (size_t)orow * D + d0 * 32 + r32) = cvtpk(v, vn); } }
    __syncthreads();
#undef BIAS
#undef RESC
#undef KBASE
#undef MASKT
#undef SEAM_K0
#undef HALF_STEP
}
#undef ROW
#undef VMW
#undef VMWN
#undef SLOAD_H
#undef SWRITE_HK
#undef SWRITE_HV
#undef SWRITE_H
DEVI void make_ref(int L, int pass, const bf16_t* Q, const bf16_t* K, const bf16_t* V, bf16_t* O, const float* KSUM, BlockRef& r) {
    const int xcd = L & 7, k = L >> 3, bh = xcd * 4 + (k >> 3), x = k & 7, qb = pass ? (NBLK - 1 - x) : x;
    const int b = bh / NH, h = bh % NH;
    r.Q = Q + (size_t)bh * S * DH; r.K = K + (size_t)bh * S * DH; r.V = V + (size_t)bh * S * DH;
    r.O = O + (size_t)b * S * D + h * DH; r.ks = KSUM + (size_t)bh * NBLK * DH; r.qb = qb;
}
DEVI void attn_phase(char* lds, const bf16_t* Q, const bf16_t* K, const bf16_t* V, bf16_t* O, const float* KSUM, int G, int c) {
    constexpr int total = NB_ * NH * (NBLK / 2);
    int L = c; if (L >= total) return;
    int pass = 0; BlockRef cur; make_ref(L, 0, Q, K, V, O, KSUM, cur);
    Seam S;
    prime(cur, lds, S);
    for (;;) {
        const bool more_pass = pass == 0, more_item = L + G < total, last = !more_pass && !more_item;
        int passn = pass + 1, Ln = L;
        if (!more_pass) { passn = 0; Ln = more_item ? L + G : L; }
        BlockRef nxt = cur; if (!last) make_ref(Ln, passn, Q, K, V, O, KSUM, nxt);
        block(cur, nxt, lds, S);
        if (last) break;
        cur = nxt; pass = passn; L = Ln;
    }
}
#undef KSWZ
#undef SBAR
}


namespace ssm {
typedef float f32x16 __attribute__((ext_vector_type(16)));
constexpr int XS_STRIDE = 272;
constexpr int WAVE_LDS = 8192 + 16 * XS_STRIDE;
constexpr int SEG_OFF = 8 * WAVE_LDS;
DEVI void ssm_abar(const float* lam_re, const float* lam_im, const float* log_dt, int g, int p, float& ar, float& ai, float& gr, float& gi) {
    const float dt = expf(log_dt[g]);
    const float lr = fminf(lam_re[g * SP + p], -1e-4f), li = lam_im[g * SP + p];
    const float mag = expf(lr * dt); ar = mag * cosf(li * dt); ai = mag * sinf(li * dt);
    const float den = lr * lr + li * li, nr = ar - 1.f;
    gr = (nr * lr + ai * li) / den; gi = (ai * lr - nr * li) / den;
}
DEVI void build_tables(int chunk, const float* lam_re, const float* lam_im, const float* log_dt, const float* b_re, const float* b_im, const float* c_re, const float* c_im, bf16_t* BBT, bf16_t* CT) {
    if (chunk < SG * 4 * 64) {
        const int g = chunk >> 8, cb = (chunk >> 6) & 3, l = chunk & 63, col = cb * 32 + (l & 31), p = col >> 1, im = col & 1;
        float ar, ai, gr, gi; ssm_abar(lam_re, lam_im, log_dt, g, p, ar, ai, gr, gi);
        unsigned w[4];
#pragma unroll
        for (int j = 0; j < 8; j += 2) { float v[2];
#pragma unroll
            for (int q = 0; q < 2; ++q) { const int c = 8 * (l >> 5) + j + q; const float br = b_re[(g * SP + p) * SC + c], bi = b_im[(g * SP + p) * SC + c]; v[q] = im ? (gr * bi + gi * br) : (gr * br - gi * bi); }
            w[j >> 1] = (unsigned)f2bf(v[0]) | ((unsigned)f2bf(v[1]) << 16); }
        *(u32x4*)(BBT + (size_t)chunk * 8) = (u32x4){w[0], w[1], w[2], w[3]};
    } else {
        const int ch2 = chunk - SG * 4 * 64, g = ch2 >> 8, ks = (ch2 >> 6) & 3, l = ch2 & 63, chn = l & 15;
        unsigned w[4];
#pragma unroll
        for (int j = 0; j < 8; j += 2) { float v[2];
#pragma unroll
            for (int q = 0; q < 2; ++q) { const int k = ks * 32 + 8 * (l >> 4) + j + q, p = k >> 1; v[q] = (k & 1) ? -c_im[((size_t)g * SC + chn) * SP + p] : c_re[((size_t)g * SC + chn) * SP + p]; }
            w[j >> 1] = (unsigned)f2bf(v[0]) | ((unsigned)f2bf(v[1]) << 16); }
        *(u32x4*)(CT + (size_t)ch2 * 8) = (u32x4){w[0], w[1], w[2], w[3]};
    }
}
DEVI float gelu_fast(float x) { const float z = 1.5957691216057308f * (x + 0.044715f * x * x * x); return x * __builtin_amdgcn_rcpf(1.f + __expf(-z)); }
template <bool OUT>
DEVI void segment(LAS unsigned char* wl, const float* Ub, bf16_t* Zb, int tbase, int lane, float ar, float ai, float& xr, float& xi,
                  const bf16x8 (&bbt)[4], const bf16x8 (&ct)[4], float dsk) {
    const int r32 = lane & 31, hi = lane >> 5;
    LAS unsigned char* bu = wl; LAS unsigned char* xs = wl + 8192;
#pragma nounroll
    for (int sc = 0; sc < 16; ++sc) {
        const int t0 = tbase + sc * 32;
        const float* up = Ub + (size_t)(t0 + r32) * SC + 8 * hi;
        const f32x4 u0 = *(const f32x4*)up, u1 = *(const f32x4*)(up + 4);
        u32x4 aw = {cvt_pk_bf16(u0[0], u0[1]), cvt_pk_bf16(u0[2], u0[3]), cvt_pk_bf16(u1[0], u1[1]), cvt_pk_bf16(u1[2], u1[3])};
        const bf16x8 afrag = *reinterpret_cast<bf16x8*>(&aw);
        f32x16 d[4];
#pragma unroll
        for (int cb = 0; cb < 4; ++cb) { d[cb] = f32x16{}; d[cb] = __builtin_amdgcn_mfma_f32_32x32x16_bf16(afrag, bbt[cb], d[cb], 0, 0, 0); }
#pragma unroll
        for (int half = 0; half < 2; ++half) {
#pragma unroll
            for (int rr = 0; rr < 8; ++rr) { const int r = half * 8 + rr, row = (r & 3) + 8 * ((r >> 2) & 1) + 4 * hi;
#pragma unroll
                for (int cb = 0; cb < 4; ++cb) *(LAS float*)(bu + row * 512 + (cb * 32 + r32) * 4) = d[cb][r]; }
#pragma unroll
            for (int t = 0; t < 16; ++t) {
                const f32x2 b = *(const LAS f32x2*)(bu + t * 512 + lane * 8);
                const float nr = ar * xr - ai * xi + b[0], ni = ar * xi + ai * xr + b[1];
                xr = nr; xi = ni;
                if (OUT) *(LAS unsigned*)(xs + t * XS_STRIDE + lane * 4) = cvt_pk_bf16(xr, xi);
            }
            if (OUT) {
                f32x4 acc = {0.f, 0.f, 0.f, 0.f};
#pragma unroll
                for (int ks = 0; ks < 4; ++ks) { const bf16x8 xa = *(const LAS bf16x8*)(xs + (lane & 15) * XS_STRIDE + ks * 64 + 16 * (lane >> 4));
                    acc = __builtin_amdgcn_mfma_f32_16x16x32_bf16(xa, ct[ks], acc, 0, 0, 0); }
#pragma unroll
                for (int r = 0; r < 4; ++r) { const int t = t0 + half * 16 + 4 * (lane >> 4) + r; const float uv = Ub[(size_t)t * SC + (lane & 15)];
                    Zb[(size_t)t * SC + (lane & 15)] = f2bf(gelu_fast(acc[r] + dsk * uv)); }
            }
        }
    }
}
DEVI void ssm_phase(LAS unsigned char* lds, const float* U, bf16_t* Z, const bf16_t* BBT, const bf16_t* CT, const float* lam_re, const float* lam_im, const float* log_dt, const float* d_skip, int G, int c) {
    const int tid = threadIdx.x, lane = tid & 63, wave = __builtin_amdgcn_readfirstlane(tid >> 6);
    LAS unsigned char* wl = lds + wave * WAVE_LDS;
    LAS f32x2* seg = (LAS f32x2*)(lds + SEG_OFF);
    for (int unit = c; unit < NB_ * SG; unit += G) {
        const int g = unit & (SG - 1);
        float ar, ai, gr, gi; ssm_abar(lam_re, lam_im, log_dt, g, lane, ar, ai, gr, gi);
        float pr = ar, pi = ai;
#pragma unroll
        for (int q = 0; q < 9; ++q) { const float nr = pr * pr - pi * pi, ni = 2.f * pr * pi; pr = nr; pi = ni; }
        bf16x8 bbt[4], ct[4];
#pragma unroll
        for (int q = 0; q < 4; ++q) { bbt[q] = *(const bf16x8*)(BBT + ((size_t)(g * 4 + q) * 64 + lane) * 8); ct[q] = *(const bf16x8*)(CT + ((size_t)(g * 4 + q) * 64 + lane) * 8); }
        const float dsk = d_skip[g * SC + (lane & 15)];
        const float* Ub = U + (size_t)unit * S * SC; bf16_t* Zb = Z + (size_t)unit * S * SC;
        float xr = 0.f, xi = 0.f;
        segment<false>(wl, Ub, Zb, wave * 512, lane, ar, ai, xr, xi, bbt, ct, dsk);
        seg[wave * 64 + lane] = (f32x2){xr, xi};
        asm volatile("s_waitcnt lgkmcnt(0)" ::: "memory");
        __syncthreads();
        xr = 0.f; xi = 0.f;
        for (int v = 0; v < wave; ++v) { const f32x2 e = seg[v * 64 + lane]; const float nr = pr * xr - pi * xi + e[0], ni = pr * xi + pi * xr + e[1]; xr = nr; xi = ni; }
        segment<true>(wl, Ub, Zb, wave * 512, lane, ar, ai, xr, xi, bbt, ct, dsk);
        __syncthreads();
    }
}
}

DEVI unsigned f2bf_u(float f) { unsigned u = __float_as_uint(f); return (u + 0x7fffu + ((u >> 16) & 1u)) >> 16; }
DEVI unsigned pk2(float lo, float hi) { return f2bf_u(lo) | (f2bf_u(hi) << 16); }
DEVI void transpose_item(const float* W, int K, int N, bf16_t* WT, int k0, int n0, int drow0, LAS float* scr, int lane) {
#pragma unroll 8
    for (int i = 0; i < 32; ++i) { const int kk = 2 * i + (lane >> 5); scr[kk * 33 + (lane & 31)] = W[(size_t)(k0 + kk) * N + n0 + (lane & 31)]; }
    asm volatile("s_waitcnt lgkmcnt(0)" ::: "memory");
    const int c = lane & 7;
#pragma unroll
    for (int j = 0; j < 4; ++j) { const int n = (lane >> 3) + 8 * j; const LAS float* s = scr + (8 * c) * 33 + n;
        u32x4 o; o.x = pk2(s[0 * 33], s[1 * 33]); o.y = pk2(s[2 * 33], s[3 * 33]); o.z = pk2(s[4 * 33], s[5 * 33]); o.w = pk2(s[6 * 33], s[7 * 33]);
        *(u32x4*)(WT + (size_t)(drow0 + n) * K + k0 + 8 * c) = o; }
    asm volatile("s_waitcnt lgkmcnt(0)" ::: "memory");
}

enum { PH_PRO = 0, PH_WIN, PH_SSM, PH_WOUT, PH_ROUTE0, PH_MOE1_0, PH_MOE2_0, PH_COMB0, PH_QKV, PH_ATTN, PH_WO, PH_ROUTE1, PH_MOE1_1, PH_MOE2_1, PH_FINAL, PH_COUNT };
struct MegaArgs { const float* in[21]; float* out; unsigned char* ws; int ph_lo, ph_hi, li, pad; };

__global__ void __launch_bounds__(NTHR, 2) mega(MegaArgs a) {
    extern __shared__ __attribute__((aligned(16))) unsigned char lds_raw[];
    LAS unsigned char* lds = (LAS unsigned char*)lds_raw;
    volatile LAS unsigned* MISC = (volatile LAS unsigned*)(lds + LDS_MISC);
    LAS int* tabI = (LAS int*)(lds + LDS_TAB);
    const int tid = threadIdx.x, lane = tid & 63, wave = __builtin_amdgcn_readfirstlane(tid >> 6);
    const int G = gridDim.x, bx = blockIdx.x;
    unsigned char* ws = a.ws;
    unsigned* ctl = (unsigned*)(ws + WS_CTL);
    bf16_t* WT_in = (bf16_t*)(ws + WS_WD); bf16_t* WT_out = WT_in + (size_t)D * D; bf16_t* WT_qkv = WT_out + (size_t)2 * D * D; bf16_t* WT_o = WT_qkv + (size_t)3 * D * D;
    bf16_t* W13 = (bf16_t*)(ws + WS_W13); bf16_t* W2T = (bf16_t*)(ws + WS_W2);
    bf16_t* XN = (bf16_t*)(ws + WS_XN); float* H = (float*)(ws + WS_H);
    float* U = (float*)(ws + WS_U); bf16_t* Z = (bf16_t*)(ws + WS_Z);
    bf16_t* Q = (bf16_t*)(ws + WS_Q); bf16_t* O = (bf16_t*)(ws + WS_O);
    bf16_t* ACT = (bf16_t*)(ws + WS_ACT); bf16_t* Y = (bf16_t*)(ws + WS_Y);
    float* KSUM = (float*)(ws + WS_CTL + CTL_KSUM);
    int* rtok = (int*)(ws + WS_RTOK); Slot* slot = (Slot*)(ws + WS_SLOT);
    bf16_t* BBT = (bf16_t*)(ws + WS_TAB2); bf16_t* CTt = BBT + (size_t)SG * 4 * 64 * 8;
    const int gwv = bx * NWAVES + wave, NGWV = G * NWAVES;
    if (tid < 32) MISC[tid] = 0u;
    __syncthreads();
    XcdBarrier bar = xcd_barrier_post(ctl + CW_BAR + a.li * XCD_BAR_WORDS, MISC + 8);
    const int lo = a.ph_lo, hi = a.ph_hi;
#define IN(k) (lo <= (k) && (k) < hi)
#define SEAM(k) do { if (IN(k) && IN((k) + 1)) xcd_barrier(bar); } while (0)

    if (IN(PH_PRO)) {
        LAS float* scr = (LAS float*)(lds + wave * 16384);
        const int gw = bx * NWAVES + wave, NGW = G * NWAVES;
        constexpr int I_IN = 16 * 32, I_OUT = 16 * 64, I_QKV = 16 * 96, I_O = 16 * 32, I_DENSE = I_IN + I_OUT + I_QKV + I_O, I_EXP = 768, NITEMS = I_DENSE + 2 * NE * I_EXP;
        for (int it = gw; it < NITEMS; it += NGW) {
            int r = it;
            if (r < I_IN) { transpose_item(a.in[4], D, D, WT_in, 64 * (r / 32), 32 * (r % 32), 32 * (r % 32), scr, lane); continue; } r -= I_IN;
            if (r < I_OUT) { const int n0 = 32 * (r % 64), bj = n0 >> 10, j = n0 & 1023; transpose_item(a.in[13], D, 2 * D, WT_out, 64 * (r / 64), n0, 256 * (j >> 7) + 128 * bj + (j & 127), scr, lane); continue; } r -= I_OUT;
            if (r < I_QKV) { transpose_item(a.in[14], D, 3 * D, WT_qkv, 64 * (r / 96), 32 * (r % 96), 32 * (r % 96), scr, lane); continue; } r -= I_QKV;
            if (r < I_O) { transpose_item(a.in[15], D, D, WT_o, 64 * (r / 32), 32 * (r % 32), 32 * (r % 32), scr, lane); continue; } r -= I_O;
            const int le = r / I_EXP; r -= le * I_EXP;
            if (r < 256) { const int n0 = 32 * (r % 16); transpose_item(a.in[18] + (size_t)le * D * FF, D, FF, W13 + (size_t)le * 1024 * D, 64 * (r / 16), n0, 256 * (n0 >> 7) + (n0 & 127), scr, lane); continue; } r -= 256;
            if (r < 256) { const int n0 = 32 * (r % 16); transpose_item(a.in[19] + (size_t)le * D * FF, D, FF, W13 + (size_t)le * 1024 * D, 64 * (r / 16), n0, 256 * (n0 >> 7) + 128 + (n0 & 127), scr, lane); continue; } r -= 256;
            transpose_item(a.in[20] + (size_t)le * FF * D, FF, D, W2T + (size_t)le * 1024 * FF, 64 * (r / 32), 32 * (r % 32), 32 * (r % 32), scr, lane);
        }
        for (int ch = bx * NTHR + tid; ch < 2 * SG * 4 * 64; ch += G * NTHR) ssm::build_tables(ch, a.in[5], a.in[6], a.in[7], a.in[8], a.in[9], a.in[10], a.in[11], BBT, CTt);
        for (int tok = gwv; tok < NTOK; tok += NGWV) tok_row<true, false, false, false>(tok, lane, a.in[0], nullptr, a.in[1], XN, nullptr, nullptr, nullptr, nullptr, nullptr, nullptr, nullptr, nullptr, nullptr);
    }
    SEAM(PH_PRO);
    if (IN(PH_WIN)) { PWin P{XN, WT_in, U, D, G, bx}; pg8::gemm_phase(lds, P); }
    SEAM(PH_WIN);
    if (IN(PH_SSM)) ssm::ssm_phase(lds, U, Z, BBT, CTt, a.in[5], a.in[6], a.in[7], a.in[12], G, bx);
    SEAM(PH_SSM);
    if (IN(PH_WOUT)) { PWout P{Z, WT_out, a.in[0], H, D, G, bx}; pg8::gemm_phase(lds, P); }
    SEAM(PH_WOUT);
    if (IN(PH_ROUTE0)) { for (int tok = gwv; tok < NTOK; tok += NGWV) tok_row<false, false, true, false>(tok, lane, nullptr, H, a.in[2], XN, nullptr, nullptr, nullptr, nullptr, a.in[16], a.in[17], slot, ctl + CW_COUNT, rtok); }
    SEAM(PH_ROUTE0);
    if (IN(PH_MOE1_0)) { moe_plan(tabI, ctl + CW_COUNT, rtok, G, bx, true); PMoe1 P{XN, W13, ACT, tabI, D, G, bx}; pg8::gemm_phase(lds, P); }
    SEAM(PH_MOE1_0);
    if (IN(PH_MOE2_0)) { moe_plan(tabI, ctl + CW_COUNT, rtok, G, bx, false); PMoe2 P{ACT, W2T, Y, tabI, FF, G, bx}; pg8::gemm_phase(lds, P); }
    SEAM(PH_MOE2_0);
    if (IN(PH_COMB0)) { for (int tok = gwv; tok < NTOK; tok += NGWV) tok_row<false, true, false, false>(tok, lane, nullptr, H, a.in[1] + D, XN, nullptr, Y, slot, ctl + CW_COUNT, nullptr, nullptr, nullptr, nullptr, nullptr); }
    SEAM(PH_COMB0);
    if (IN(PH_QKV)) { PQkv P{XN, WT_qkv, Q, KSUM, D, G, bx}; pg8::gemm_phase(lds, P); }
    SEAM(PH_QKV);
    if (IN(PH_ATTN)) attn::attn_phase((char*)lds_raw, Q, Q + (size_t)NTOK * D, Q + (size_t)2 * NTOK * D, O, KSUM, G, bx);
    SEAM(PH_ATTN);
    if (IN(PH_WO)) { PWo P{O, WT_o, H, D, G, bx}; pg8::gemm_phase(lds, P); }
    SEAM(PH_WO);
    if (IN(PH_ROUTE1)) { for (int tok = gwv; tok < NTOK; tok += NGWV) tok_row<false, false, true, false>(tok, lane, nullptr, H, a.in[2] + D, XN, nullptr, nullptr, nullptr, nullptr, a.in[16] + (size_t)D * NGRP, a.in[17] + (size_t)D * NE, slot, ctl + CW_COUNT + 32, rtok); }
    SEAM(PH_ROUTE1);
    if (IN(PH_MOE1_1)) { moe_plan(tabI, ctl + CW_COUNT + 32, rtok, G, bx, true); PMoe1 P{XN, W13 + (size_t)NE * 1024 * D, ACT, tabI, D, G, bx}; pg8::gemm_phase(lds, P); }
    SEAM(PH_MOE1_1);
    if (IN(PH_MOE2_1)) { moe_plan(tabI, ctl + CW_COUNT + 32, rtok, G, bx, false); PMoe2 P{ACT, W2T + (size_t)NE * 1024 * FF, Y, tabI, FF, G, bx}; pg8::gemm_phase(lds, P); }
    SEAM(PH_MOE2_1);
    if (IN(PH_FINAL)) { for (int tok = gwv; tok < NTOK; tok += NGWV) tok_row<false, true, false, true>(tok, lane, nullptr, H, a.in[3], nullptr, a.out, Y, slot, ctl + CW_COUNT + 32, nullptr, nullptr, nullptr, nullptr, nullptr); }
#undef IN
#undef SEAM
}

#ifndef ONE_LAUNCH
#define ONE_LAUNCH 1
#endif
#ifndef FASTMASK
#define FASTMASK ((1u << PH_PRO) | (1u << PH_WIN) | (1u << PH_WOUT) | (1u << PH_QKV) | (1u << PH_WO) | (1u << PH_MOE1_0) | (1u << PH_MOE2_0) | (1u << PH_MOE1_1) | (1u << PH_MOE2_1) | (1u << PH_ATTN) | (1u << PH_SSM))
#endif
extern "C" void kernel_launch(void* const* d_in, const int* in_sizes, int n_in, void* d_out, int out_size, void* d_ws, size_t ws_size, hipStream_t stream) {
    if (n_in != 21 || in_sizes[0] != NTOK * D || out_size != NTOK * D || ws_size < WS_END) {
        fprintf(stderr, "kernel_launch: unexpected shapes (n_in %d, in0 %d, out %d, ws %zu)\n", n_in, n_in > 0 ? in_sizes[0] : -1, out_size, ws_size); return; }
    static int grid = 0;
    if (grid == 0) {
        int dev = 0, cus = 0;
        if (hipGetDevice(&dev) != hipSuccess || hipDeviceGetAttribute(&cus, hipDeviceAttributeMultiprocessorCount, dev) != hipSuccess || cus <= 0) cus = 256;
        if (hipFuncSetAttribute((const void*)mega, hipFuncAttributeMaxDynamicSharedMemorySize, LDS_BYTES) != hipSuccess) fprintf(stderr, "kernel_launch: hipFuncSetAttribute failed\n");
        int per_cu = 0; (void)hipOccupancyMaxActiveBlocksPerMultiprocessor(&per_cu, (const void*)mega, NTHR, LDS_BYTES); (void)hipGetLastError();
        if (per_cu < 1) fprintf(stderr, "kernel_launch: occupancy query says %d blocks per CU\n", per_cu);
        grid = cus;
    }
    const float* x = (const float*)d_in[0]; const float* ln_mix = (const float*)d_in[1]; const float* ln_ffn = (const float*)d_in[2]; const float* ln_final = (const float*)d_in[3];
    const float* w_in = (const float*)d_in[4]; const float* lam_re = (const float*)d_in[5]; const float* lam_im = (const float*)d_in[6]; const float* log_dt = (const float*)d_in[7];
    const float* b_re = (const float*)d_in[8]; const float* b_im = (const float*)d_in[9]; const float* c_re = (const float*)d_in[10]; const float* c_im = (const float*)d_in[11];
    const float* ssm_d = (const float*)d_in[12]; const float* w_out = (const float*)d_in[13]; const float* w_qkv = (const float*)d_in[14]; const float* w_o = (const float*)d_in[15];
    const float* w_group = (const float*)d_in[16]; const float* w_expert = (const float*)d_in[17]; const float* w1 = (const float*)d_in[18]; const float* w3 = (const float*)d_in[19]; const float* w2 = (const float*)d_in[20];
    unsigned char* ws = (unsigned char*)d_ws; float* out = (float*)d_out;
    unsigned* ctl = (unsigned*)(ws + WS_CTL); float* KSUM = (float*)(ws + WS_CTL + CTL_KSUM); float* tab = (float*)(ws + WS_TAB);
    Slot* slot = (Slot*)(ws + WS_SLOT); int* rtok = (int*)(ws + WS_RTOK);
    bf16_t* XN = (bf16_t*)(ws + WS_XN); float* H = (float*)(ws + WS_H);
    float* U = (float*)(ws + WS_U); bf16_t* Z = (bf16_t*)(ws + WS_Z);
    bf16_t* Q = (bf16_t*)(ws + WS_Q); bf16_t* Kb = (bf16_t*)(ws + WS_K); bf16_t* Vb = (bf16_t*)(ws + WS_V); bf16_t* O = (bf16_t*)(ws + WS_O);
    bf16_t* ACT = (bf16_t*)(ws + WS_ACT); bf16_t* Y = (bf16_t*)(ws + WS_Y);
    (void)hipMemsetAsync(ws + WS_CTL, 0, CTL_BYTES, stream);
    MegaArgs ma{};
    for (int i = 0; i < 21; ++i) ma.in[i] = (const float*)d_in[i];
    ma.out = out; ma.ws = ws;
    int li = 0;
    auto fast = [&](int ph) { return (FASTMASK >> ph) & 1u; };
    auto mega_launch = [&](int lo, int hi) { ma.ph_lo = lo; ma.ph_hi = hi; ma.li = li++; ma.pad = 0; hipLaunchKernelGGL(mega, dim3(grid), dim3(NTHR), LDS_BYTES, stream, ma); };
#if ONE_LAUNCH
    mega_launch(0, PH_COUNT);
    return;
#endif
    if (fast(PH_PRO)) mega_launch(PH_PRO, PH_PRO + 1);
    k_ssm_params<<<SG, SP, 0, stream>>>(lam_re, lam_im, log_dt, b_re, b_im, tab);
    k_tok<true, false, false, false><<<NTOK / 4, 256, 0, stream>>>(x, nullptr, ln_mix, XN, nullptr, nullptr, nullptr, nullptr, nullptr, nullptr, nullptr, nullptr, nullptr);
    if (fast(PH_WIN)) mega_launch(PH_WIN, PH_WIN + 1);
    else k_gemm_naive<FWin, false><<<dim3(D / 64, NTOK / 64), 256, 0, stream>>>(FWin{XN, w_in, U});
    if (fast(PH_SSM)) mega_launch(PH_SSM, PH_SSM + 1);
    else k_ssm_naive<<<NB_ * SG, 64, 0, stream>>>(U, tab, c_re, c_im, ssm_d, Z);
    if (fast(PH_WOUT)) mega_launch(PH_WOUT, PH_WOUT + 1);
    else k_gemm_naive<FWout, true><<<dim3(D / 64, NTOK / 64), 256, 0, stream>>>(FWout{Z, w_out, x, H});
    for (int layer = 0; layer < 2; ++layer) {
        unsigned* cnt = ctl + CW_COUNT + 32 * layer;
        if (layer == 1) {
            k_tok<false, true, false, false><<<NTOK / 4, 256, 0, stream>>>(nullptr, H, ln_mix + D, XN, nullptr, Y, slot, ctl + CW_COUNT, nullptr, nullptr, nullptr, nullptr, nullptr);
            if (fast(PH_QKV)) mega_launch(PH_QKV, PH_QKV + 1);
            else {
                k_gemm_naive<FQkv, false><<<dim3(3 * D / 64, NTOK / 64), 256, 0, stream>>>(FQkv{XN, w_qkv, Q});
                k_ksum_naive<<<NB_ * NH * NBLK, 128, 0, stream>>>(Kb, KSUM);
            }
            if (fast(PH_ATTN)) mega_launch(PH_ATTN, PH_ATTN + 1);
            else k_attn_naive<<<NB_ * NH * S / 4, 256, 0, stream>>>(Q, Kb, Vb, KSUM, O);
            if (fast(PH_WO)) mega_launch(PH_WO, PH_WO + 1);
            else k_gemm_naive<FWo, false><<<dim3(D / 64, NTOK / 64), 256, 0, stream>>>(FWo{O, w_o, H});
        }
        k_tok<false, false, true, false><<<NTOK / 4, 256, 0, stream>>>(nullptr, H, ln_ffn + layer * D, XN, nullptr, nullptr, nullptr, nullptr,
                                                                      w_group + (size_t)layer * D * NGRP, w_expert + (size_t)layer * D * NE, slot, cnt, rtok);
        const int ph1 = layer ? PH_MOE1_1 : PH_MOE1_0, ph2 = layer ? PH_MOE2_1 : PH_MOE2_0;
        if (fast(ph1)) mega_launch(ph1, ph1 + 1);
        else k_gemm_naive<FMoe1, true><<<dim3(FF / 64, MAXROWS / 64), 256, 0, stream>>>(FMoe1{XN, w1 + (size_t)layer * NE * D * FF, w3 + (size_t)layer * NE * D * FF, cnt, rtok, ACT});
        if (fast(ph2)) mega_launch(ph2, ph2 + 1);
        else k_gemm_naive<FMoe2, false><<<dim3(D / 64, MAXROWS / 64), 256, 0, stream>>>(FMoe2{ACT, w2 + (size_t)layer * NE * FF * D, cnt, Y});
    }
    k_tok<false, true, false, true><<<NTOK / 4, 256, 0, stream>>>(nullptr, H, ln_final, nullptr, out, Y, slot, ctl + CW_COUNT + 32, nullptr, nullptr, nullptr, nullptr, nullptr);
}
```

```cpp
#include <hip/hip_runtime.h>
#include <cstdint>
#include <cstdio>

#define DEVI __device__ __forceinline__
typedef unsigned short bf16_t;

constexpr int D = 1024, NB_ = 4, S = 4096, NTOK = NB_ * S;
constexpr int SG = 64, SC = 16, SP = 64;
constexpr int NH = 8, HD = 128, MBLK = 256, NBLK = S / MBLK, TOPK = 3;
constexpr int NGRP = 4, EPG = 8, NE = 32, FF = 512;
constexpr float EPS = 1e-6f;
constexpr int ECAP = 16384;
constexpr int MAXROWS = 40960;

constexpr size_t MiB = 1u << 20;
constexpr size_t WS_CTL = 0, CTL_BYTES = 1 * MiB;
constexpr size_t WS_TAB = 1 * MiB;
constexpr size_t WS_SLOT = 2 * MiB;
constexpr size_t WS_RTOK = 3 * MiB;
constexpr size_t WS_TAB2 = 5 * MiB;
constexpr size_t WS_WD = 8 * MiB;
constexpr size_t WS_W13 = 24 * MiB;
constexpr size_t WS_W2 = 152 * MiB;
constexpr size_t WS_XN = 216 * MiB;
constexpr size_t WS_H = 248 * MiB;
constexpr size_t WS_MIX = 312 * MiB;
constexpr size_t WS_U = WS_MIX, WS_Z = WS_MIX + 64 * MiB;
constexpr size_t WS_Q = WS_MIX, WS_K = WS_MIX + 32 * MiB, WS_V = WS_MIX + 64 * MiB, WS_O = WS_MIX + 96 * MiB;
constexpr size_t WS_ACT = WS_MIX, WS_Y = WS_MIX + 40 * MiB;
constexpr size_t WS_END = 440 * MiB;
constexpr int CW_COUNT = 0;
constexpr int CW_BAR = 4096;
constexpr size_t CTL_KSUM = 512 * 1024;
constexpr int TAB_ABAR = 0;
constexpr int TAB_BB = 8192;

struct Slot { int epos; float gate; };

DEVI float bf2f(bf16_t b) { return __uint_as_float(((unsigned)b) << 16); }
DEVI bf16_t f2bf(float f) { unsigned u = __float_as_uint(f); u += 0x7fffu + ((u >> 16) & 1u); return (bf16_t)(u >> 16); }
DEVI float wave_sum(float v) {
#pragma unroll
    for (int o = 32; o >= 1; o >>= 1) v += __shfl_xor(v, o);
    return v;
}
DEVI float wave_max(float v) {
#pragma unroll
    for (int o = 32; o >= 1; o >>= 1) v = fmaxf(v, __shfl_xor(v, o));
    return v;
}
DEVI float sigmoidf_(float x) { return 1.f / (1.f + __expf(-x)); }
DEVI float gelu_tanh(float x) { const float t = tanhf(0.7978845608028654f * (x + 0.044715f * x * x * x)); return 0.5f * x * (1.f + t); }

__global__ void k_ssm_params(const float* lam_re, const float* lam_im, const float* log_dt, const float* b_re, const float* b_im, float* tab) {
    const int g = blockIdx.x, p = threadIdx.x;
    const float dt = expf(log_dt[g]);
    const float lr = fminf(lam_re[g * SP + p], -1e-4f), li = lam_im[g * SP + p];
    const float mag = expf(lr * dt), ar = mag * cosf(li * dt), ai = mag * sinf(li * dt);
    const float den = lr * lr + li * li, nr = ar - 1.f;
    const float gr = (nr * lr + ai * li) / den, gi = (ai * lr - nr * li) / den;
    tab[TAB_ABAR + (g * SP + p) * 2 + 0] = ar; tab[TAB_ABAR + (g * SP + p) * 2 + 1] = ai;
    for (int c = 0; c < SC; ++c) {
        const float br = b_re[(g * SP + p) * SC + c], bi = b_im[(g * SP + p) * SC + c];
        tab[TAB_BB + ((g * SP + p) * SC + c) * 2 + 0] = gr * br - gi * bi;
        tab[TAB_BB + ((g * SP + p) * SC + c) * 2 + 1] = gr * bi + gi * br;
    }
}

template <bool FROMX, bool COMBINE, bool ROUTER, bool FINAL>
DEVI void tok_row(int tok, int lane, const float* Xin, float* H, const float* gain, bf16_t* XN, float* out,
                  const bf16_t* Y, const Slot* slot_prev, const unsigned* cnt_prev,
                  const float* w_group, const float* w_expert, Slot* slot, unsigned* cnt, int* row_token) {
    const float* src = FROMX ? Xin : H;
    float4 v[4];
#pragma unroll
    for (int j = 0; j < 4; ++j) v[j] = *(const float4*)(src + (size_t)tok * D + 4 * lane + 256 * j);
    if (COMBINE) {
        int c = lane < NE ? (int)cnt_prev[lane] : 0; int pc = (c + 255) & ~255; int incl = pc;
#pragma unroll
        for (int o = 1; o < 32; o <<= 1) { int t = __shfl_up(incl, o); if ((lane & 31) >= o) incl += t; }
        const int excl = incl - pc;
#pragma unroll
        for (int k = 0; k < 2; ++k) {
            const Slot s = slot_prev[tok * 2 + k];
            const int e = s.epos >> 14, pos = s.epos & (ECAP - 1);
            const int rb = __shfl(excl, e);
            const bf16_t* yr = Y + (size_t)(rb + pos) * D;
#pragma unroll
            for (int j = 0; j < 4; ++j) {
                const uint2 w = *(const uint2*)(yr + 4 * lane + 256 * j);
                v[j].x += s.gate * __uint_as_float(w.x << 16); v[j].y += s.gate * __uint_as_float(w.x & 0xffff0000u);
                v[j].z += s.gate * __uint_as_float(w.y << 16); v[j].w += s.gate * __uint_as_float(w.y & 0xffff0000u);
            }
        }
        if (!FINAL) {
#pragma unroll
            for (int j = 0; j < 4; ++j) *(float4*)(H + (size_t)tok * D + 4 * lane + 256 * j) = v[j];
        }
    }
    float ss = 0.f;
#pragma unroll
    for (int j = 0; j < 4; ++j) ss += v[j].x * v[j].x + v[j].y * v[j].y + v[j].z * v[j].z + v[j].w * v[j].w;
    ss = wave_sum(ss);
    const float rstd = rsqrtf(ss * (1.f / D) + EPS);
#pragma unroll
    for (int j = 0; j < 4; ++j) {
        const float4 gg = *(const float4*)(gain + 4 * lane + 256 * j);
        v[j].x *= rstd * gg.x; v[j].y *= rstd * gg.y; v[j].z *= rstd * gg.z; v[j].w *= rstd * gg.w;
    }
    if (FINAL) {
#pragma unroll
        for (int j = 0; j < 4; ++j) *(float4*)(out + (size_t)tok * D + 4 * lane + 256 * j) = v[j];
    } else {
#pragma unroll
        for (int j = 0; j < 4; ++j) {
            uint2 w; w.x = (unsigned)f2bf(v[j].x) | ((unsigned)f2bf(v[j].y) << 16); w.y = (unsigned)f2bf(v[j].z) | ((unsigned)f2bf(v[j].w) << 16);
            *(uint2*)(XN + (size_t)tok * D + 4 * lane + 256 * j) = w;
        }
    }
    if (ROUTER) {
        float lg[NGRP], le[NE];
#pragma unroll
        for (int i = 0; i < NGRP; ++i) lg[i] = 0.f;
#pragma unroll
        for (int i = 0; i < NE; ++i) le[i] = 0.f;
#pragma unroll
        for (int j = 0; j < 4; ++j) {
            const float xv[4] = {v[j].x, v[j].y, v[j].z, v[j].w};
#pragma unroll
            for (int i = 0; i < 4; ++i) {
                const int k = 4 * lane + 256 * j + i;
                const float4 wg = *(const float4*)(w_group + (size_t)k * NGRP);
                lg[0] += xv[i] * wg.x; lg[1] += xv[i] * wg.y; lg[2] += xv[i] * wg.z; lg[3] += xv[i] * wg.w;
#pragma unroll
                for (int q = 0; q < 8; ++q) {
                    const float4 we = *(const float4*)(w_expert + (size_t)k * NE + 4 * q);
                    le[4 * q + 0] += xv[i] * we.x; le[4 * q + 1] += xv[i] * we.y; le[4 * q + 2] += xv[i] * we.z; le[4 * q + 3] += xv[i] * we.w;
                }
            }
        }
#pragma unroll
        for (int i = 0; i < NGRP; ++i) lg[i] = wave_sum(lg[i]);
#pragma unroll
        for (int i = 0; i < NE; ++i) le[i] = wave_sum(le[i]);
        int gi = 0; float gm = lg[0];
#pragma unroll
        for (int i = 1; i < NGRP; ++i) if (lg[i] > gm) { gm = lg[i]; gi = i; }
        float gs = 0.f;
#pragma unroll
        for (int i = 0; i < NGRP; ++i) gs += __expf(lg[i] - gm);
        const float g_gate = 1.f / gs;
        float ev[EPG];
#pragma unroll
        for (int i = 0; i < EPG; ++i) { float t = le[i];
#pragma unroll
            for (int q = 1; q < NGRP; ++q) t = (gi == q) ? le[q * EPG + i] : t;
            ev[i] = t; }
        int i0 = 0; float m0 = ev[0];
#pragma unroll
        for (int i = 1; i < EPG; ++i) if (ev[i] > m0) { m0 = ev[i]; i0 = i; }
        int i1 = -1; float m1 = -3.0e38f;
#pragma unroll
        for (int i = 0; i < EPG; ++i) if (i != i0 && ev[i] > m1) { m1 = ev[i]; i1 = i; }
        const float p1 = __expf(m1 - m0);
        const float g0 = g_gate / (1.f + p1), g1 = g_gate * p1 / (1.f + p1);
        if (lane == 0) {
            const int e0 = gi * EPG + i0, e1 = gi * EPG + i1;
            const int pos0 = (int)atomicAdd(&cnt[e0], 1u), pos1 = (int)atomicAdd(&cnt[e1], 1u);
            slot[tok * 2 + 0].epos = e0 * ECAP + pos0; slot[tok * 2 + 0].gate = g0;
            slot[tok * 2 + 1].epos = e1 * ECAP + pos1; slot[tok * 2 + 1].gate = g1;
            row_token[e0 * ECAP + pos0] = tok; row_token[e1 * ECAP + pos1] = tok;
        }
    }
}

template <bool FROMX, bool COMBINE, bool ROUTER, bool FINAL>
__global__ __launch_bounds__(256) void k_tok(const float* Xin, float* H, const float* gain, bf16_t* XN, float* out,
                                             const bf16_t* Y, const Slot* slot_prev, const unsigned* cnt_prev,
                                             const float* w_group, const float* w_expert, Slot* slot, unsigned* cnt, int* row_token) {
    tok_row<FROMX, COMBINE, ROUTER, FINAL>(blockIdx.x * 4 + (threadIdx.x >> 6), threadIdx.x & 63, Xin, H, gain, XN, out, Y, slot_prev, cnt_prev, w_group, w_expert, slot, cnt, row_token);
}

template <class F, bool DUAL>
__global__ __launch_bounds__(256) void k_gemm_naive(F f) {
    __shared__ float As[16][68];
    __shared__ float B0s[16][64];
    __shared__ float B1s[16][64];
    __shared__ int sh_ctx[4];
    const int tid = threadIdx.x, tx = tid & 15, ty = tid >> 4;
    const int rt = blockIdx.y, col0 = blockIdx.x * 64;
    if (tid == 0) f.setup(rt, sh_ctx);
    __syncthreads();
    if (sh_ctx[0] < 0) return;
    const int c0 = sh_ctx[0], c1 = sh_ctx[1], c2 = sh_ctx[2];
    const float* b0 = f.b0(c0); const float* b1 = DUAL ? f.b1(c0) : nullptr;
    const int ldb = f.ldb(), K = f.K();
    float acc0[4][4], acc1[4][4];
#pragma unroll
    for (int i = 0; i < 4; ++i)
#pragma unroll
        for (int j = 0; j < 4; ++j) { acc0[i][j] = 0.f; acc1[i][j] = 0.f; }
    for (int k0 = 0; k0 < K; k0 += 16) {
#pragma unroll
        for (int i = 0; i < 4; ++i) { const int e = tid + 256 * i, r = e >> 4, kk = e & 15; As[kk][r] = f.a(rt, r, k0 + kk, c0, c1, c2); }
#pragma unroll
        for (int i = 0; i < 4; ++i) { const int e = tid + 256 * i, kk = e >> 6, c = e & 63; B0s[kk][c] = b0[(size_t)(k0 + kk) * ldb + col0 + c]; if (DUAL) B1s[kk][c] = b1[(size_t)(k0 + kk) * ldb + col0 + c]; }
        __syncthreads();
#pragma unroll
        for (int kk = 0; kk < 16; ++kk) {
            float a[4], b[4], bb[4];
#pragma unroll
            for (int i = 0; i < 4; ++i) a[i] = As[kk][ty * 4 + i];
#pragma unroll
            for (int j = 0; j < 4; ++j) { b[j] = B0s[kk][tx * 4 + j]; bb[j] = DUAL ? B1s[kk][tx * 4 + j] : 0.f; }
#pragma unroll
            for (int i = 0; i < 4; ++i)
#pragma unroll
                for (int j = 0; j < 4; ++j) { acc0[i][j] += a[i] * b[j]; if (DUAL) acc1[i][j] += a[i] * bb[j]; }
        }
        __syncthreads();
    }
#pragma unroll
    for (int i = 0; i < 4; ++i)
#pragma unroll
        for (int j = 0; j < 4; ++j) f.epi(rt, ty * 4 + i, col0 + tx * 4 + j, acc0[i][j], acc1[i][j], c0, c1, c2);
}

struct FWin {
    const bf16_t* XN; const float* W; float* U;
    DEVI void setup(int, int* c) const { c[0] = 0; }
    DEVI const float* b0(int) const { return W; } DEVI const float* b1(int) const { return nullptr; }
    DEVI int ldb() const { return D; } DEVI int K() const { return D; }
    DEVI float a(int rt, int r, int k, int, int, int) const { return bf2f(XN[(size_t)(rt * 64 + r) * D + k]); }
    DEVI void epi(int rt, int r, int col, float v0, float, int, int, int) const {
        const int row = rt * 64 + r, b = row / S, t = row % S, g = col >> 4, c = col & 15;
        U[(((size_t)b * SG + g) * S + t) * SC + c] = v0;
    }
};
struct FWout {
    const bf16_t* Z; const float* W; const float* X; float* H;
    DEVI void setup(int, int* c) const { c[0] = 0; }
    DEVI const float* b0(int) const { return W; } DEVI const float* b1(int) const { return W + D; }
    DEVI int ldb() const { return 2 * D; } DEVI int K() const { return D; }
    DEVI float a(int rt, int r, int k, int, int, int) const { const int row = rt * 64 + r, b = row / S, t = row % S; return bf2f(Z[(((size_t)b * SG + (k >> 4)) * S + t) * SC + (k & 15)]); }
    DEVI void epi(int rt, int r, int col, float v0, float v1, int, int, int) const {
        const size_t o = (size_t)(rt * 64 + r) * D + col; H[o] = X[o] + v0 * sigmoidf_(v1);
    }
};
DEVI void expert_of_rowtile(const unsigned* cnt, int row0, int* c) {
    int base = 0; c[0] = -1; c[1] = 0; c[2] = 0;
    for (int i = 0; i < NE; ++i) { const int n = (int)cnt[i], pc = (n + 255) & ~255; if (row0 < base + pc) { c[0] = i; c[1] = base; c[2] = n; return; } base += pc; }
}
struct FMoe1 {
    const bf16_t* XN; const float* W1; const float* W3; const unsigned* cnt; const int* row_token; bf16_t* ACT;
    DEVI void setup(int rt, int* c) const { expert_of_rowtile(cnt, rt * 64, c); }
    DEVI const float* b0(int e) const { return W1 + (size_t)e * D * FF; } DEVI const float* b1(int e) const { return W3 + (size_t)e * D * FF; }
    DEVI int ldb() const { return FF; } DEVI int K() const { return D; }
    DEVI float a(int rt, int r, int k, int e, int base, int n) const { const int pos = rt * 64 + r - base; const int tok = pos < n ? row_token[e * ECAP + pos] : 0; return bf2f(XN[(size_t)tok * D + k]); }
    DEVI void epi(int rt, int r, int col, float v0, float v1, int, int, int) const { ACT[(size_t)(rt * 64 + r) * FF + col] = f2bf(v0 * sigmoidf_(v0) * v1); }
};
struct FMoe2 {
    const bf16_t* ACT; const float* W2; const unsigned* cnt; bf16_t* Y;
    DEVI void setup(int rt, int* c) const { expert_of_rowtile(cnt, rt * 64, c); }
    DEVI const float* b0(int e) const { return W2 + (size_t)e * FF * D; } DEVI const float* b1(int) const { return nullptr; }
    DEVI int ldb() const { return D; } DEVI int K() const { return FF; }
    DEVI float a(int rt, int r, int k, int, int, int) const { return bf2f(ACT[(size_t)(rt * 64 + r) * FF + k]); }
    DEVI void epi(int rt, int r, int col, float v0, float, int, int, int) const { Y[(size_t)(rt * 64 + r) * D + col] = f2bf(v0); }
};
struct FQkv {
    const bf16_t* XN; const float* W; bf16_t* Q;
    DEVI void setup(int, int* c) const { c[0] = 0; }
    DEVI const float* b0(int) const { return W; } DEVI const float* b1(int) const { return nullptr; }
    DEVI int ldb() const { return 3 * D; } DEVI int K() const { return D; }
    DEVI float a(int rt, int r, int k, int, int, int) const { return bf2f(XN[(size_t)(rt * 64 + r) * D + k]); }
    DEVI void epi(int rt, int r, int col, float v0, float, int, int, int) const {
        const int row = rt * 64 + r, b = row / S, t = row % S, which = col >> 10, h = (col & 1023) >> 7, d = col & 127;
        Q[(size_t)which * ((size_t)NTOK * D) + (((size_t)b * NH + h) * S + t) * HD + d] = f2bf(v0);
    }
};
struct FWo {
    const bf16_t* O; const float* W; float* H;
    DEVI void setup(int, int* c) const { c[0] = 0; }
    DEVI const float* b0(int) const { return W; } DEVI const float* b1(int) const { return nullptr; }
    DEVI int ldb() const { return D; } DEVI int K() const { return D; }
    DEVI float a(int rt, int r, int k, int, int, int) const { return bf2f(O[(size_t)(rt * 64 + r) * D + k]); }
    DEVI void epi(int rt, int r, int col, float v0, float, int, int, int) const { H[(size_t)(rt * 64 + r) * D + col] += v0; }
};

__global__ __launch_bounds__(64) void k_ssm_naive(const float* U, const float* tab, const float* c_re, const float* c_im, const float* d_skip, bf16_t* Z) {
    __shared__ float xs[64][130];
    __shared__ float us[64][16];
    __shared__ float cr[16][64], ci[16][64];
    const int bg = blockIdx.x, g = bg % SG, p = threadIdx.x;
    float bbr[SC], bbi[SC];
#pragma unroll
    for (int c = 0; c < SC; ++c) { bbr[c] = tab[TAB_BB + ((g * SP + p) * SC + c) * 2]; bbi[c] = tab[TAB_BB + ((g * SP + p) * SC + c) * 2 + 1]; }
    const float ar = tab[TAB_ABAR + (g * SP + p) * 2], ai = tab[TAB_ABAR + (g * SP + p) * 2 + 1];
    for (int i = p; i < 16 * 64; i += 64) { cr[i / 64][i % 64] = c_re[(size_t)g * 1024 + i]; ci[i / 64][i % 64] = c_im[(size_t)g * 1024 + i]; }
    float dsk[SC];
#pragma unroll
    for (int c = 0; c < SC; ++c) dsk[c] = d_skip[g * SC + c];
    float xr = 0.f, xi = 0.f;
    const float* Ub = U + (size_t)bg * S * SC;
    bf16_t* Zb = Z + (size_t)bg * S * SC;
    for (int t0 = 0; t0 < S; t0 += 64) {
        __syncthreads();
        for (int i = p; i < 64 * 16; i += 64) us[i / 16][i % 16] = Ub[(size_t)t0 * SC + i];
        __syncthreads();
        for (int t = 0; t < 64; ++t) {
            float br = 0.f, bi = 0.f;
#pragma unroll
            for (int c = 0; c < SC; ++c) { const float u = us[t][c]; br += u * bbr[c]; bi += u * bbi[c]; }
            const float nr = ar * xr - ai * xi + br, ni = ar * xi + ai * xr + bi;
            xr = nr; xi = ni; xs[t][2 * p] = xr; xs[t][2 * p + 1] = xi;
        }
        __syncthreads();
        const int t = p;
        float y[SC];
#pragma unroll
        for (int c = 0; c < SC; ++c) y[c] = 0.f;
        for (int q = 0; q < SP; ++q) { const float a = xs[t][2 * q], b = xs[t][2 * q + 1];
#pragma unroll
            for (int c = 0; c < SC; ++c) y[c] += a * cr[c][q] - b * ci[c][q]; }
#pragma unroll
        for (int c = 0; c < SC; ++c) { const float v = y[c] + dsk[c] * us[t][c]; Zb[(size_t)(t0 + t) * SC + c] = f2bf(gelu_tanh(v)); }
    }
}

__global__ __launch_bounds__(256) void k_ksum_naive(const bf16_t* Kb, float* KSUM) {
    const int bhn = blockIdx.x, bh = bhn / NBLK, n = bhn % NBLK, d = threadIdx.x;
    if (d >= HD) return;
    float s = 0.f;
    for (int j = 0; j < MBLK; ++j) s += bf2f(Kb[((size_t)bh * S + n * MBLK + j) * HD + d]);
    KSUM[(size_t)bhn * HD + d] = s;
}
__global__ __launch_bounds__(256) void k_attn_naive(const bf16_t* Q, const bf16_t* Kb, const bf16_t* Vb, const float* KSUM, bf16_t* O) {
    __shared__ float qs[4][HD];
    __shared__ float sc[4][1024];
    const int lane = threadIdx.x & 63, wid = threadIdx.x >> 6;
    const int gq = blockIdx.x * 4 + wid;
    const int bh = gq / S, s = gq % S, cur = s / MBLK;
    const bf16_t* qp = Q + (size_t)gq * HD;
    qs[wid][lane] = bf2f(qp[lane]); qs[wid][lane + 64] = bf2f(qp[lane + 64]);
    __syncthreads();
    float gate[NBLK];
#pragma unroll
    for (int n = 0; n < NBLK; ++n) {
        float t = 0.f;
        if (n < cur) t = qs[wid][lane] * KSUM[((size_t)bh * NBLK + n) * HD + lane] + qs[wid][lane + 64] * KSUM[((size_t)bh * NBLK + n) * HD + lane + 64];
        t = wave_sum(t) * (1.f / MBLK);
        gate[n] = n < cur ? t : -1e30f;
    }
    unsigned blkpack = 0; int nsel = 0;
    unsigned used = 0;
    for (int k = 0; k < TOPK; ++k) {
        int bi = -1; float bm = -3.0e38f;
#pragma unroll
        for (int n = 0; n < NBLK; ++n) if (!((used >> n) & 1u) && gate[n] > bm) { bm = gate[n]; bi = n; }
        used |= 1u << bi;
        if (bi < cur) { blkpack |= (unsigned)bi << (4 * nsel); ++nsel; }
    }
    blkpack |= (unsigned)cur << (4 * nsel); ++nsel;
    const float scale = 0.08838834764831845f;
    float mx = -3.0e38f;
    for (int i = 0; i < nsel; ++i) {
        const int n = (int)((blkpack >> (4 * i)) & 15u);
        for (int j = lane; j < MBLK; j += 64) {
            const int key = n * MBLK + j;
            const bf16_t* kp = Kb + ((size_t)bh * S + key) * HD;
            float a = 0.f;
            for (int d = 0; d < HD; d += 8) {
                const uint4 w = *(const uint4*)(kp + d);
                a += qs[wid][d] * __uint_as_float(w.x << 16) + qs[wid][d + 1] * __uint_as_float(w.x & 0xffff0000u)
                   + qs[wid][d + 2] * __uint_as_float(w.y << 16) + qs[wid][d + 3] * __uint_as_float(w.y & 0xffff0000u)
                   + qs[wid][d + 4] * __uint_as_float(w.z << 16) + qs[wid][d + 5] * __uint_as_float(w.z & 0xffff0000u)
                   + qs[wid][d + 6] * __uint_as_float(w.w << 16) + qs[wid][d + 7] * __uint_as_float(w.w & 0xffff0000u);
            }
            a *= scale;
            if (key > s) a = -1e30f;
            sc[wid][i * MBLK + j] = a;
            mx = fmaxf(mx, a);
        }
    }
    mx = wave_max(mx);
    float sum = 0.f;
    for (int j = lane; j < nsel * MBLK; j += 64) { const float pv = __expf(sc[wid][j] - mx); sc[wid][j] = pv; sum += pv; }
    sum = wave_sum(sum);
    __syncthreads();
    float o0 = 0.f, o1 = 0.f;
    for (int i = 0; i < nsel; ++i) {
        const int n = (int)((blkpack >> (4 * i)) & 15u);
        for (int j = 0; j < MBLK; ++j) {
            const float pv = sc[wid][i * MBLK + j];
            const unsigned w = *(const unsigned*)(Vb + ((size_t)bh * S + n * MBLK + j) * HD + 2 * lane);
            o0 += pv * __uint_as_float(w << 16); o1 += pv * __uint_as_float(w & 0xffff0000u);
        }
    }
    const float inv = 1.f / sum;
    const int b = bh / NH, h = bh % NH;
    const unsigned w = (unsigned)f2bf(o0 * inv) | ((unsigned)f2bf(o1 * inv) << 16);
    *(unsigned*)(O + ((size_t)b * S + s) * D + h * HD + 2 * lane) = w;
}


#define LAS __attribute__((address_space(3)))
#define GAS __attribute__((address_space(1)))
typedef short bf16x8 __attribute__((ext_vector_type(8)));
typedef float f32x4 __attribute__((ext_vector_type(4)));
typedef float f32x2 __attribute__((ext_vector_type(2)));
typedef unsigned u32x4 __attribute__((ext_vector_type(4)));
typedef unsigned u32x2 __attribute__((ext_vector_type(2)));
constexpr int NWAVES = 8, NTHR = 512;
constexpr int LDS_RING = 131072;
constexpr int LDS_TAB = LDS_RING;
constexpr int LDS_MISC = LDS_RING + 12288;
constexpr int LDS_BYTES = 147456;

DEVI unsigned cvt_pk_bf16(float lo, float hi) { unsigned r; asm volatile("v_cvt_pk_bf16_f32 %0, %1, %2" : "=v"(r) : "v"(lo), "v"(hi)); return r; }
DEVI float fast_sigmoid(float x) { return __builtin_amdgcn_rcpf(1.f + __expf(-x)); }

#define XB_TMO      128
#define XB_XCNT(j)  (256  + 64 * (j))
#define XB_XSUB(j)  (1280 + 64 * (j))
#define XB_XGEN(j)  (2304 + 64 * (j))
#define XB_TOP      3328
#define XB_TOPGEN   3392
#define XCD_BAR_WORDS 3456
#define XB_SPIN_CAP (1u << 18)
DEVI unsigned xb_ld(unsigned* p)              { return __hip_atomic_load(p, __ATOMIC_RELAXED, __HIP_MEMORY_SCOPE_AGENT); }
DEVI unsigned xb_add(unsigned* p, unsigned v) { return __hip_atomic_fetch_add(p, v, __ATOMIC_RELAXED, __HIP_MEMORY_SCOPE_AGENT); }
DEVI unsigned xb_xcc_id() { return (unsigned)__builtin_amdgcn_s_getreg((3 << 11) | 20) & 0xFu; }
#define XB_SPIN(cond, bar) do { unsigned _sp = 0; while (cond) { __builtin_amdgcn_s_sleep(1); \
    if ((++_sp & 255u) == 0u) { if (xb_ld(&(bar)[XB_TMO])) break; if (_sp > XB_SPIN_CAP) { atomicAdd(&(bar)[XB_TMO], 1u); break; } } } } while (0)
struct XcdBarrier { unsigned* bar; unsigned x; volatile LAS unsigned* st; };
DEVI XcdBarrier xcd_barrier_post(unsigned* bar, volatile LAS unsigned* st) {
    XcdBarrier b; b.bar = bar; b.x = xb_xcc_id(); b.st = st;
    if (threadIdx.x == 0) (void)xb_add(&bar[XB_XCNT(b.x)], 1u);
    return b;
}
DEVI void xcd_barrier_complete(unsigned* bar, unsigned x, unsigned& nloc, unsigned& nx) {
    const unsigned G = gridDim.x * gridDim.y * gridDim.z;
    unsigned sum, cnt, mine, sp = 0u;
    for (;;) {
        sum = 0u; cnt = 0u; mine = 0u;
#pragma unroll
        for (unsigned j = 0; j < 16; ++j) { const unsigned c = xb_ld(&bar[XB_XCNT(j)]); sum += c; cnt += (c > 0u) ? 1u : 0u; mine = (j == x) ? c : mine; }
        if (sum == G) break;
        __builtin_amdgcn_s_sleep(1);
        if ((++sp & 255u) == 0u) { if (xb_ld(&bar[XB_TMO])) break; if (sp > XB_SPIN_CAP) { atomicAdd(&bar[XB_TMO], 1u); break; } }
    }
    nloc = mine > 0u ? mine : 1u; nx = cnt > 0u ? cnt : 1u;
}
DEVI void xcd_barrier(const XcdBarrier& b) {
    asm volatile("s_waitcnt vmcnt(0)" ::: "memory");
    __syncthreads();
    if (threadIdx.x == 0) {
        unsigned* bar = b.bar;
        __builtin_amdgcn_s_waitcnt(0);
        unsigned nloc = b.st[0], nx = b.st[1];
        if (nloc == 0u) { xcd_barrier_complete(bar, b.x, nloc, nx); b.st[0] = nloc; b.st[1] = nx; }
        const unsigned old = xb_add(&bar[XB_XSUB(b.x)], 1u);
        const unsigned gen = old / nloc;
        if (old + 1u == (gen + 1u) * nloc) {
            __builtin_amdgcn_fence(__ATOMIC_RELEASE, "agent");
            asm volatile("s_waitcnt vmcnt(0)" ::: "memory");
            const unsigned og = xb_add(&bar[XB_TOP], 1u);
            const unsigned tg = og / nx;
            if (og + 1u == (tg + 1u) * nx) xb_add(&bar[XB_TOPGEN], 1u);
            else XB_SPIN(xb_ld(&bar[XB_TOPGEN]) == tg, bar);
            __builtin_amdgcn_fence(__ATOMIC_ACQUIRE, "agent");
            xb_add(&bar[XB_XGEN(b.x)], 1u);
            asm volatile("s_waitcnt vmcnt(0)" ::: "memory");
        } else {
            XB_SPIN(xb_ld(&bar[XB_XGEN(b.x)]) == gen, bar);
            __builtin_amdgcn_fence(__ATOMIC_ACQUIRE, "agent");
            asm volatile("s_waitcnt vmcnt(0)" ::: "memory");
        }
    }
    __syncthreads();
}

namespace pg8 {
constexpr int BM = 256, BK = 64, HALF = 128, HTB = HALF * BK * 2, STAGE_BYTES = 8 * HTB, NXCD = 8, WGM = 8;
__host__ __device__ __forceinline__ int lds_byte(int r, int c) { const int st = (r >> 4) * 2 + (c >> 5), rr = r & 15, cc = c & 31, ob = rr * 64 + cc * 2; return st * 1024 + (ob ^ (((ob >> 9) & 1) << 5)); }
__host__ __device__ __forceinline__ void stage_rc(int b, int& R, int& C) { const int st = b / 1024, sb = b % 1024, swz = sb ^ (((sb >> 9) & 1) << 5); R = (st >> 1) * 16 + swz / 64; C = (st & 1) * 32 + (swz % 64) / 2; }
__host__ __device__ __forceinline__ int perm32(int rho) { const int n = rho >> 4, i = rho & 15; return 8 * (i >> 2) + 4 * n + (i & 3); }
struct Unit { int pm, pn, e; };
DEVI bool static_next(int i, int nM, int nN, int G, int c, Unit& u) {
    const int nwg = nM * nN; const long L = (long)i * G + c; if (L >= nwg) return false;
    int wgid = (int)L; { const int q = nwg / NXCD, r = nwg % NXCD, xcd = wgid % NXCD, off = wgid / NXCD; wgid = (xcd < r ? xcd * (q + 1) : r * (q + 1) + (xcd - r) * q) + off; }
    const int nig = WGM * nN, gid = wgid / nig, fm = gid * WGM, gsz = (nM - fm) < WGM ? (nM - fm) : WGM;
    u.pm = fm + ((wgid % nig) % gsz); u.pn = (wgid % nig) / gsz; u.e = 0; return true;
}

template <class P>
DEVI void gemm_phase(LAS unsigned char* lds, const P& S) {
    const int tid = threadIdx.x, wid = __builtin_amdgcn_readfirstlane(tid >> 6), lane = tid & 63, wr = wid >> 2, wc = wid & 3, fr = lane & 15, fq = lane >> 4;
    const int K = S.K, nt = K / BK;
    int R[2], C[2]; unsigned voffB[2];
#pragma unroll
    for (int i = 0; i < 2; ++i) { stage_rc(tid * 16 + i * 8192, R[i], C[i]); const int Rb = P::PERM ? ((R[i] & ~31) + perm32(R[i] & 31)) : R[i]; voffB[i] = (unsigned)(Rb * K + C[i]) * 2u; }
    const size_t kstep = (size_t)(BK * 2);
    const size_t hstep = (size_t)HALF * K * 2;
    const unsigned ldsw = (unsigned)wid * 1024u;
    const int aoff = lds_byte(wr * 64 + fr, fq * 8), boff = lds_byte(wc * 32 + fr, fq * 8);
    const char* const abase = S.a_base();
#define PG8_SA(b, h) (((b) * 2 + (h)) * HTB)
#define PG8_SB(b, h) ((4 + (b) * 2 + (h)) * HTB)
#define PG8_STAGE(bufoff, gbase, voff) do { _Pragma("unroll") for (int _i = 0; _i < 2; ++_i) \
        __builtin_amdgcn_global_load_lds((const unsigned*)((const char*)(gbase) + (voff)[_i]), (LAS unsigned*)(lds + (bufoff) + ldsw + _i * 8192), 16, 0, 0); } while (0)
#define PG8_LDA(dst, b, h) do { _Pragma("unroll") for (int m = 0; m < 4; ++m) _Pragma("unroll") for (int k = 0; k < 2; ++k) dst[m][k] = *(const LAS bf16x8*)(lds + PG8_SA(b, h) + aoff + m * 2048 + k * 1024); } while (0)
#define PG8_LDB(dst, b, h) do { _Pragma("unroll") for (int n = 0; n < 2; ++n) _Pragma("unroll") for (int k = 0; k < 2; ++k) dst[n][k] = *(const LAS bf16x8*)(lds + PG8_SB(b, h) + boff + n * 2048 + k * 1024); } while (0)
#define PG8_MMA(ai, bj, At, Bt) do { __builtin_amdgcn_s_setprio(1); _Pragma("unroll") for (int m = 0; m < 4; ++m) _Pragma("unroll") for (int n = 0; n < 2; ++n) _Pragma("unroll") for (int k = 0; k < 2; ++k) \
        acc[ai][bj][m][n] = __builtin_amdgcn_mfma_f32_16x16x32_bf16(Bt[n][k], At[m][k], acc[ai][bj][m][n], 0, 0, 0); __builtin_amdgcn_s_setprio(0); } while (0)
#define PG8_WAIT_V(n) asm volatile("s_waitcnt vmcnt(" #n ")" ::: "memory")
#define PG8_WAIT_L(n) asm volatile("s_waitcnt lgkmcnt(" #n ")" ::: "memory")
#define PG8_BAR __builtin_amdgcn_s_barrier()
#define PG8_SCHED __builtin_amdgcn_sched_barrier(0)
    Unit cur, nxt; int ui = 0;
    if (!S.next(0, cur)) return;
    f32x4 acc[2][2][4][2];
#pragma unroll
    for (int a = 0; a < 2; ++a)
#pragma unroll
        for (int b = 0; b < 2; ++b)
#pragma unroll
            for (int m = 0; m < 4; ++m)
#pragma unroll
                for (int n = 0; n < 2; ++n) acc[a][b][m][n] = (f32x4){0.f, 0.f, 0.f, 0.f};
    bf16x8 At[4][2], B0[2][2], B1[2][2];
    unsigned oc0[2], oc1[2], on0[2], on1[2];
    S.a_off(cur, 0, R, C, oc0); S.a_off(cur, 1, R, C, oc1);
    const char* cB = S.b_base(cur);
    {
        const char* a0 = abase; const char* a1 = abase + P::KSTEP_A;
        PG8_STAGE(PG8_SB(0, 0), cB, voffB); PG8_STAGE(PG8_SB(0, 1), cB + hstep, voffB); PG8_STAGE(PG8_SA(0, 0), a0, oc0); PG8_STAGE(PG8_SA(0, 1), a0, oc1);
        if (wr == 1) PG8_BAR;
        PG8_WAIT_V(2); PG8_BAR;
        PG8_STAGE(PG8_SB(1, 0), cB + kstep, voffB); PG8_STAGE(PG8_SA(1, 0), a1, oc0); PG8_STAGE(PG8_SB(1, 1), cB + hstep + kstep, voffB);
        PG8_WAIT_V(6); PG8_BAR;
    }
    for (;;) {
        const bool has_next = S.next(ui + 1, nxt);
        if (has_next) { S.a_off(nxt, 0, R, C, on0); S.a_off(nxt, 1, R, C, on1); }
        else { on0[0] = oc0[0]; on0[1] = oc0[1]; on1[0] = oc1[0]; on1[1] = oc1[1]; }
        const char* nB = has_next ? S.b_base(nxt) : cB;
#pragma nounroll
        for (int t = 0; t < nt; t += 2) {
            const bool last = (t == nt - 2);
            const char* a1 = abase + (size_t)(t + 1) * P::KSTEP_A;
            const char* a2 = last ? abase : abase + (size_t)(t + 2) * P::KSTEP_A; const char* b2 = last ? nB : cB + (size_t)(t + 2) * kstep;
            const char* a3 = a2 + P::KSTEP_A; const char* b3 = b2 + kstep;
            unsigned o20[2], o21[2];
            o20[0] = last ? on0[0] : oc0[0]; o20[1] = last ? on0[1] : oc0[1]; o21[0] = last ? on1[0] : oc1[0]; o21[1] = last ? on1[1] : oc1[1];
            PG8_LDB(B0, 0, 0); PG8_LDB(B1, 0, 1); PG8_SCHED; PG8_LDA(At, 0, 0); PG8_STAGE(PG8_SA(1, 1), a1, oc1);
            PG8_WAIT_V(8); PG8_WAIT_L(0); PG8_BAR; PG8_MMA(0, 0, At, B0); PG8_MMA(0, 1, At, B1); PG8_BAR; PG8_SCHED;
            PG8_LDA(At, 0, 1); PG8_STAGE(PG8_SB(0, 0), b2, voffB); PG8_STAGE(PG8_SB(0, 1), b2 + hstep, voffB); PG8_STAGE(PG8_SA(0, 0), a2, o20);
            PG8_WAIT_V(8); PG8_WAIT_L(0); PG8_BAR; PG8_MMA(1, 0, At, B0); PG8_MMA(1, 1, At, B1); PG8_BAR; PG8_SCHED;
            PG8_LDB(B0, 1, 0); PG8_LDB(B1, 1, 1); PG8_SCHED; PG8_LDA(At, 1, 0); PG8_STAGE(PG8_SA(0, 1), a2, o21);
            PG8_WAIT_V(8); PG8_WAIT_L(0); PG8_BAR; PG8_MMA(0, 0, At, B0); PG8_MMA(0, 1, At, B1); PG8_BAR; PG8_SCHED;
            PG8_LDA(At, 1, 1); PG8_STAGE(PG8_SB(1, 0), b3, voffB); PG8_STAGE(PG8_SB(1, 1), b3 + hstep, voffB); PG8_STAGE(PG8_SA(1, 0), a3, o20);
            PG8_WAIT_V(8); PG8_WAIT_L(0); PG8_BAR; PG8_MMA(1, 0, At, B0); PG8_MMA(1, 1, At, B1); PG8_BAR; PG8_SCHED;
        }
        if (wr == 0) PG8_BAR;
        S.epi(acc, cur, wr, wc, fr, fq);
        if (!has_next) break;
#pragma unroll
        for (int a = 0; a < 2; ++a)
#pragma unroll
            for (int b = 0; b < 2; ++b)
#pragma unroll
                for (int m = 0; m < 4; ++m)
#pragma unroll
                    for (int n = 0; n < 2; ++n) acc[a][b][m][n] = (f32x4){0.f, 0.f, 0.f, 0.f};
        cur = nxt; cB = nB; ++ui;
        oc0[0] = on0[0]; oc0[1] = on0[1]; oc1[0] = on1[0]; oc1[1] = on1[1];
        if (wr == 1) PG8_BAR;
    }
    PG8_WAIT_V(0);
    PG8_BAR;
#undef PG8_SA
#undef PG8_SB
#undef PG8_STAGE
#undef PG8_LDA
#undef PG8_LDB
#undef PG8_MMA
#undef PG8_WAIT_V
#undef PG8_WAIT_L
#undef PG8_BAR
#undef PG8_SCHED
}
}
using pg8::Unit;

struct PWin {
    static constexpr bool PERM = false; static constexpr unsigned KSTEP_A = 128;
    const bf16_t* A; const bf16_t* Bt; float* U; int K, G, c;
    DEVI const char* a_base() const { return (const char*)A; }
    DEVI bool next(int i, Unit& u) const { return pg8::static_next(i, NTOK / 256, D / 256, G, c, u); }
    DEVI void a_off(const Unit& u, int h, const int (&R)[2], const int (&C)[2], unsigned (&o)[2]) const {
#pragma unroll
        for (int i = 0; i < 2; ++i) o[i] = (unsigned)((u.pm * 256 + h * 128 + R[i]) * D + C[i]) * 2u; }
    DEVI const char* b_base(const Unit& u) const { return (const char*)(Bt + (size_t)u.pn * 256 * D); }
    DEVI void epi(const f32x4 (&acc)[2][2][4][2], const Unit& u, int wr, int wc, int fr, int fq) const {
#pragma unroll
        for (int ai = 0; ai < 2; ++ai)
#pragma unroll
            for (int m = 0; m < 4; ++m) { const int row = u.pm * 256 + wr * 64 + fr + ai * 128 + m * 16, b = row >> 12, t = row & (S - 1);
#pragma unroll
                for (int bj = 0; bj < 2; ++bj)
#pragma unroll
                    for (int n = 0; n < 2; ++n) { const int g = u.pn * 16 + bj * 8 + wc * 2 + n;
                        *(f32x4*)(U + (((size_t)b * SG + g) * S + t) * SC + 4 * fq) = acc[ai][bj][m][n]; } }
    }
};
struct PWout {
    static constexpr bool PERM = false; static constexpr unsigned KSTEP_A = 4u * S * SC * 2u;
    const bf16_t* A; const bf16_t* Bt; const float* X; float* H; int K, G, c;
    DEVI const char* a_base() const { return (const char*)A; }
    DEVI bool next(int i, Unit& u) const { return pg8::static_next(i, NTOK / 256, 8, G, c, u); }
    DEVI void a_off(const Unit& u, int h, const int (&R)[2], const int (&C)[2], unsigned (&o)[2]) const {
#pragma unroll
        for (int i = 0; i < 2; ++i) { const int row = u.pm * 256 + h * 128 + R[i], b = row >> 12, t = row & (S - 1);
            o[i] = (unsigned)(b * SG * S + t) * 32u + (unsigned)(C[i] >> 4) * (unsigned)(S * SC * 2) + (unsigned)(C[i] & 15) * 2u; } }
    DEVI const char* b_base(const Unit& u) const { return (const char*)(Bt + (size_t)u.pn * 256 * D); }
    DEVI void epi(const f32x4 (&acc)[2][2][4][2], const Unit& u, int wr, int wc, int fr, int fq) const {
#pragma unroll
        for (int ai = 0; ai < 2; ++ai)
#pragma unroll
            for (int m = 0; m < 4; ++m) { const int row = u.pm * 256 + wr * 64 + fr + ai * 128 + m * 16;
#pragma unroll
                for (int n = 0; n < 2; ++n) { const size_t o = (size_t)row * D + u.pn * 128 + wc * 32 + n * 16 + 4 * fq;
                    const f32x4 xv = *(const f32x4*)(X + o); const f32x4 v = acc[ai][0][m][n], g = acc[ai][1][m][n]; f32x4 r;
#pragma unroll
                    for (int j = 0; j < 4; ++j) r[j] = xv[j] + v[j] * fast_sigmoid(g[j]);
                    *(f32x4*)(H + o) = r; } }
    }
};
struct PQkv {
    static constexpr bool PERM = true; static constexpr unsigned KSTEP_A = 128;
    const bf16_t* A; const bf16_t* Bt; bf16_t* Q; float* KSUM; int K, G, c;
    DEVI const char* a_base() const { return (const char*)A; }
    DEVI bool next(int i, Unit& u) const { return pg8::static_next(i, NTOK / 256, 12, G, c, u); }
    DEVI void a_off(const Unit& u, int h, const int (&R)[2], const int (&C)[2], unsigned (&o)[2]) const {
#pragma unroll
        for (int i = 0; i < 2; ++i) o[i] = (unsigned)((u.pm * 256 + h * 128 + R[i]) * D + C[i]) * 2u; }
    DEVI const char* b_base(const Unit& u) const { return (const char*)(Bt + (size_t)u.pn * 256 * D); }
    DEVI void epi(const f32x4 (&acc)[2][2][4][2], const Unit& u, int wr, int wc, int fr, int fq) const {
        const int which = u.pn >> 2, b = u.pm >> 4, nb = u.pm & 15;
        bf16_t* base = Q + (size_t)which * ((size_t)NTOK * D);
#pragma unroll
        for (int ai = 0; ai < 2; ++ai)
#pragma unroll
            for (int m = 0; m < 4; ++m) { const int t = nb * 256 + wr * 64 + fr + ai * 128 + m * 16;
#pragma unroll
                for (int bj = 0; bj < 2; ++bj) { const int h = (u.pn & 3) * 2 + bj; const f32x4 v0 = acc[ai][bj][m][0], v1 = acc[ai][bj][m][1];
                    u32x4 w; w.x = cvt_pk_bf16(v0[0], v0[1]); w.y = cvt_pk_bf16(v0[2], v0[3]); w.z = cvt_pk_bf16(v1[0], v1[1]); w.w = cvt_pk_bf16(v1[2], v1[3]);
                    *(u32x4*)(base + (((size_t)b * NH + h) * S + t) * HD + wc * 32 + 8 * fq) = w; } }
        if (which == 1) {
#pragma unroll
            for (int bj = 0; bj < 2; ++bj) { const int h = (u.pn & 3) * 2 + bj;
#pragma unroll
                for (int n = 0; n < 2; ++n)
#pragma unroll
                    for (int j = 0; j < 4; ++j) { float s = 0.f;
#pragma unroll
                        for (int ai = 0; ai < 2; ++ai)
#pragma unroll
                            for (int m = 0; m < 4; ++m) s += acc[ai][bj][m][n][j];
                        s += __shfl_xor(s, 1); s += __shfl_xor(s, 2); s += __shfl_xor(s, 4); s += __shfl_xor(s, 8);
                        if (fr == 0) atomicAdd(KSUM + (((size_t)b * NH + h) * NBLK + nb) * HD + wc * 32 + 8 * fq + 4 * n + j, s); } }
        }
    }
};
struct PWo {
    static constexpr bool PERM = false; static constexpr unsigned KSTEP_A = 128;
    const bf16_t* A; const bf16_t* Bt; float* H; int K, G, c;
    DEVI const char* a_base() const { return (const char*)A; }
    DEVI bool next(int i, Unit& u) const { return pg8::static_next(i, NTOK / 256, D / 256, G, c, u); }
    DEVI void a_off(const Unit& u, int h, const int (&R)[2], const int (&C)[2], unsigned (&o)[2]) const {
#pragma unroll
        for (int i = 0; i < 2; ++i) o[i] = (unsigned)((u.pm * 256 + h * 128 + R[i]) * D + C[i]) * 2u; }
    DEVI const char* b_base(const Unit& u) const { return (const char*)(Bt + (size_t)u.pn * 256 * D); }
    DEVI void epi(const f32x4 (&acc)[2][2][4][2], const Unit& u, int wr, int wc, int fr, int fq) const {
#pragma unroll
        for (int ai = 0; ai < 2; ++ai)
#pragma unroll
            for (int m = 0; m < 4; ++m) { const int row = u.pm * 256 + wr * 64 + fr + ai * 128 + m * 16;
#pragma unroll
                for (int bj = 0; bj < 2; ++bj)
#pragma unroll
                    for (int n = 0; n < 2; ++n) { float* p = H + (size_t)row * D + u.pn * 256 + bj * 128 + wc * 32 + n * 16 + 4 * fq;
                        *(f32x4*)p = *(const f32x4*)p + acc[ai][bj][m][n]; } }
    }
};
constexpr int MOE_MAXU = 4;
DEVI bool moe_next(const volatile LAS int* tabI, int i, int G, int c, Unit& u) {
    const int L = i * G + c, T = tabI[64]; if (L >= T * 4) return false;
    u.pm = L >> 2; u.pn = L & 3; int e = 0;
#pragma unroll 1
    for (int j = 1; j < NE; ++j) if (tabI[32 + j] <= u.pm * 256) e = j; else break;
    u.e = e; return true;
}
DEVI void moe_plan(LAS int* tabI, const unsigned* cnt, const int* row_token, int G, int c, bool want_tok) {
    const int tid = threadIdx.x;
    if (tid < 64) {
        int n = tid < NE ? (int)__hip_atomic_load(cnt + (tid & 31), __ATOMIC_RELAXED, __HIP_MEMORY_SCOPE_AGENT) : 0; if (tid >= NE) n = 0;
        const int pc = (n + 255) & ~255; int incl = pc;
#pragma unroll
        for (int o = 1; o < 32; o <<= 1) { const int t = __shfl_up(incl, o); if ((tid & 31) >= o) incl += t; }
        if (tid < NE) { tabI[tid] = n; tabI[32 + tid] = incl - pc; }
        if (tid == NE - 1) tabI[64] = incl >> 8;
    }
    __syncthreads();
    if (want_tok) {
        for (int ui = 0; ui < MOE_MAXU; ++ui) { Unit u; if (!moe_next(tabI, ui, G, c, u)) break;
            const int n = tabI[u.e], base = tabI[32 + u.e];
            for (int r = tid; r < 256; r += NTHR) { const int pos = u.pm * 256 + r - base; tabI[128 + 256 * ui + r] = pos < n ? row_token[u.e * ECAP + pos] : 0; } }
    }
    asm volatile("s_waitcnt vmcnt(0) lgkmcnt(0)" ::: "memory");
    __syncthreads();
}
struct PMoe1 {
    static constexpr bool PERM = true; static constexpr unsigned KSTEP_A = 128;
    const bf16_t* A; const bf16_t* Bt; bf16_t* ACT; const volatile LAS int* tabI; int K, G, c;
    DEVI const char* a_base() const { return (const char*)A; }
    DEVI bool next(int i, Unit& u) const { const bool ok = moe_next(tabI, i, G, c, u); u.e |= i << 8; return ok; }
    DEVI void a_off(const Unit& u, int h, const int (&R)[2], const int (&C)[2], unsigned (&o)[2]) const {
#pragma unroll
        for (int i = 0; i < 2; ++i) { const int tok = tabI[128 + 256 * (u.e >> 8) + h * 128 + R[i]]; o[i] = (unsigned)(tok * D + C[i]) * 2u; } }
    DEVI const char* b_base(const Unit& u) const { return (const char*)(Bt + ((size_t)(u.e & 255) * 1024 + (size_t)u.pn * 256) * D); }
    DEVI void epi(const f32x4 (&acc)[2][2][4][2], const Unit& u, int wr, int wc, int fr, int fq) const {
#pragma unroll
        for (int ai = 0; ai < 2; ++ai)
#pragma unroll
            for (int m = 0; m < 4; ++m) { const int row = u.pm * 256 + wr * 64 + fr + ai * 128 + m * 16; float r[8];
#pragma unroll
                for (int n = 0; n < 2; ++n)
#pragma unroll
                    for (int j = 0; j < 4; ++j) { const float a = acc[ai][0][m][n][j], b = acc[ai][1][m][n][j]; r[4 * n + j] = a * fast_sigmoid(a) * b; }
                u32x4 w; w.x = cvt_pk_bf16(r[0], r[1]); w.y = cvt_pk_bf16(r[2], r[3]); w.z = cvt_pk_bf16(r[4], r[5]); w.w = cvt_pk_bf16(r[6], r[7]);
                *(u32x4*)(ACT + (size_t)row * FF + u.pn * 128 + wc * 32 + 8 * fq) = w; }
    }
};
struct PMoe2 {
    static constexpr bool PERM = true; static constexpr unsigned KSTEP_A = 128;
    const bf16_t* A; const bf16_t* Bt; bf16_t* Y; const volatile LAS int* tabI; int K, G, c;
    DEVI const char* a_base() const { return (const char*)A; }
    DEVI bool next(int i, Unit& u) const { return moe_next(tabI, i, G, c, u); }
    DEVI void a_off(const Unit& u, int h, const int (&R)[2], const int (&C)[2], unsigned (&o)[2]) const {
#pragma unroll
        for (int i = 0; i < 2; ++i) o[i] = (unsigned)((u.pm * 256 + h * 128 + R[i]) * FF + C[i]) * 2u; }
    DEVI const char* b_base(const Unit& u) const { return (const char*)(Bt + ((size_t)u.e * 1024 + (size_t)u.pn * 256) * FF); }
    DEVI void epi(const f32x4 (&acc)[2][2][4][2], const Unit& u, int wr, int wc, int fr, int fq) const {
#pragma unroll
        for (int ai = 0; ai < 2; ++ai)
#pragma unroll
            for (int m = 0; m < 4; ++m) { const int row = u.pm * 256 + wr * 64 + fr + ai * 128 + m * 16;
#pragma unroll
                for (int bj = 0; bj < 2; ++bj) { const f32x4 v0 = acc[ai][bj][m][0], v1 = acc[ai][bj][m][1];
                    u32x4 w; w.x = cvt_pk_bf16(v0[0], v0[1]); w.y = cvt_pk_bf16(v0[2], v0[3]); w.z = cvt_pk_bf16(v1[0], v1[1]); w.w = cvt_pk_bf16(v1[2], v1[3]);
                    *(u32x4*)(Y + (size_t)row * D + u.pn * 256 + bj * 128 + wc * 32 + 8 * fq) = w; } }
    }
};


namespace attn {
typedef short s16x4 __attribute__((ext_vector_type(4)));
typedef float f32x16 __attribute__((ext_vector_type(16)));
constexpr float SCALE = 0.08838834764831845f;
constexpr float THR = 8.f;
constexpr int NW = 8, QBLK = 32, KVBLK = 64, QB = NW * QBLK, DH = 128;
constexpr int SHM_V = KVBLK * DH * 2, SHM_K = KVBLK * DH * 2;
constexpr int ATT_LDS = 2 * SHM_V + 2 * SHM_K + NW * 64 * 4;
#define KSWZ(row, colB) ((row) * 256 + ((colB) ^ (((row) & 7) << 4)))
#define SBAR() __builtin_amdgcn_sched_barrier(0)
DEVI int v_st(int k, int c) { const int kk = (k & ~0xC) | ((k & 4) << 1) | ((k & 8) >> 1); return ((kk >> 3) * 4 + (c >> 5)) * 512 + ((kk & 7) * 32 + (c & 31)) * 2; }
DEVI int v_rd_base(int lane) { return ((lane & 3) << 3) | (((lane >> 2) & 3) << 6) | (((lane >> 4) & 1) << 5) | (((lane >> 5) & 1) << 8); }
constexpr int v_rd_off(int d0, int ks, int half) { return d0 * 512 + ks * 4096 + half * 2048; }
DEVI int crow(int r, int hi) { return (r & 3) + 8 * (r >> 2) + 4 * hi; }
DEVI unsigned cvtpk(float lo, float hi) { unsigned r; asm volatile("v_cvt_pk_bf16_f32 %0, %1, %2" : "=v"(r) : "v"(lo), "v"(hi)); return r; }
DEVI bf16x8 load8(const bf16_t* p) { return *reinterpret_cast<const bf16x8*>(p); }
DEVI void mask_tile(f32x16& p0, f32x16& p1, int dq) {
    const float NEG = -__builtin_inff();
#pragma unroll
    for (int r = 0; r < 16; ++r) {
        const int c = (r & 3) + 8 * (r >> 2);
        if (dq - c < 0) p0[r] = NEG;
        if (dq - c - 32 < 0) p1[r] = NEG;
    }
}
DEVI void partialSM(f32x16& p0, f32x16& p1, float& m_reg, float& mn, float& alpha) {
    float pmax = p0[0]; for (int r = 1; r < 16; ++r) pmax = fmaxf(pmax, p0[r]); for (int r = 0; r < 16; ++r) pmax = fmaxf(pmax, p1[r]);
    { auto rr = __builtin_amdgcn_permlane32_swap(__float_as_uint(pmax), __float_as_uint(pmax), false, false);
      pmax = fmaxf(__uint_as_float(rr[0]), __uint_as_float(rr[1])); }
    constexpr float C2 = 1.4426950408889634f * SCALE;
    if (__builtin_expect(__all((pmax - m_reg) * SCALE <= THR), 1)) { mn = m_reg; alpha = 1.f; }
    else { mn = fmaxf(m_reg, pmax); alpha = __builtin_amdgcn_exp2f((m_reg - mn) * C2); m_reg = mn; }
    const float mnL = -mn * C2;
    for (int r = 0; r < 16; ++r) p0[r] = fmaf(p0[r], C2, mnL); for (int r = 0; r < 16; ++r) p1[r] = fmaf(p1[r], C2, mnL);
    for (int r = 0; r < 16; ++r) p0[r] = __builtin_amdgcn_exp2f(p0[r]);
}
DEVI void finishSM(f32x16& p0, f32x16& p1, float alpha, float& l_reg, bf16x8& pa0, bf16x8& pa1, bf16x8& pa2, bf16x8& pa3) {
    for (int r = 0; r < 16; ++r) p1[r] = __builtin_amdgcn_exp2f(p1[r]);
    float ps = 0; for (int r = 0; r < 16; ++r) ps += p0[r]; for (int r = 0; r < 16; ++r) ps += p1[r];
    { auto rr = __builtin_amdgcn_permlane32_swap(__float_as_uint(ps), __float_as_uint(ps), false, false);
      ps = __uint_as_float(rr[0]) + __uint_as_float(rr[1]); }
    l_reg = l_reg * alpha + ps;
#define PK4(P, B_, OUT) do { unsigned a0 = cvtpk(P[B_+0], P[B_+1]), a1 = cvtpk(P[B_+2], P[B_+3]);                          \
        unsigned b0 = cvtpk(P[B_+4], P[B_+5]), b1 = cvtpk(P[B_+6], P[B_+7]);                                             \
        auto r0 = __builtin_amdgcn_permlane32_swap(a0, b0, false, false); auto r1 = __builtin_amdgcn_permlane32_swap(a1, b1, false, false); \
        u32x4 w = {r0[0], r1[0], r0[1], r1[1]}; OUT = *reinterpret_cast<bf16x8*>(&w); } while (0)
    PK4(p0, 0, pa0); PK4(p0, 8, pa1); PK4(p1, 0, pa2); PK4(p1, 8, pa3);
#undef PK4
}
template <int KB>
DEVI void qkt(f32x16& p0, f32x16& p1, const char* K_lds, int r32, int hi, const bf16x8* qr, float bias) {
#pragma unroll
    for (int r = 0; r < 16; ++r) { p0[r] = bias; p1[r] = bias; }
    const char* kb[4];
#pragma unroll
    for (int dd = 0; dd < 4; ++dd) kb[dd] = K_lds + KB * SHM_K + KSWZ(r32, (dd * 16 + hi * 8) * 2);
#pragma unroll
    for (int d0 = 0; d0 < 8; ++d0) { const char* a = kb[d0 & 3] + (d0 >> 2) * 128;
        bf16x8 b0 = *reinterpret_cast<const bf16x8*>(a);
        bf16x8 b1 = *reinterpret_cast<const bf16x8*>(a + 32 * 256);
        p0 = __builtin_amdgcn_mfma_f32_32x32x16_bf16(b0, qr[d0], p0, 0, 0, 0);
        p1 = __builtin_amdgcn_mfma_f32_32x32x16_bf16(b1, qr[d0], p1, 0, 0, 0); }
}
template <int VB>
DEVI void pv_tile(f32x16* o, int vb0, bf16x8 pa0, bf16x8 pa1, bf16x8 pa2, bf16x8 pa3) {
#define TRRD(dst, off) asm volatile("ds_read_b64_tr_b16 %0, %1 offset:%2" : "=&v"(dst) : "v"(vb0), "i"(off) : "memory")
#define PV_D0(d0) do { s16x4 l0, l1, l2, l3, h0, h1, h2, h3; constexpr int b_ = VB * SHM_V + v_rd_off(d0, 0, 0); \
        TRRD(l0, b_); TRRD(h0, b_ + 2048); TRRD(l1, b_ + 4096); TRRD(h1, b_ + 6144); TRRD(l2, b_ + 8192); TRRD(h2, b_ + 10240); TRRD(l3, b_ + 12288); TRRD(h3, b_ + 14336); \
        asm volatile("s_waitcnt lgkmcnt(0)" ::: "memory"); SBAR();   \
        o[d0] = __builtin_amdgcn_mfma_f32_32x32x16_bf16(pa0, (bf16x8){l0[0], l0[1], l0[2], l0[3], h0[0], h0[1], h0[2], h0[3]}, o[d0], 0, 0, 0);   \
        o[d0] = __builtin_amdgcn_mfma_f32_32x32x16_bf16(pa1, (bf16x8){l1[0], l1[1], l1[2], l1[3], h1[0], h1[1], h1[2], h1[3]}, o[d0], 0, 0, 0);   \
        o[d0] = __builtin_amdgcn_mfma_f32_32x32x16_bf16(pa2, (bf16x8){l2[0], l2[1], l2[2], l2[3], h2[0], h2[1], h2[2], h2[3]}, o[d0], 0, 0, 0);   \
        o[d0] = __builtin_amdgcn_mfma_f32_32x32x16_bf16(pa3, (bf16x8){l3[0], l3[1], l3[2], l3[3], h3[0], h3[1], h3[2], h3[3]}, o[d0], 0, 0, 0); } while (0)
    PV_D0(0); PV_D0(1); PV_D0(2); PV_D0(3);
#undef PV_D0
#undef TRRD
}
struct BlockRef { const bf16_t* Q; const bf16_t* K; const bf16_t* V; bf16_t* O; const float* ks; int qb; };
struct Seam { bf16x8 qr[8]; bf16x8 st_v0, st_v1, st_k0, st_k1; };
#define ROW(p, k0, rr) ((p) + (size_t)((k0) + (rr)) * DH + sc)
#define VMW() asm volatile("s_waitcnt vmcnt(0)" ::: "memory")
#define VMWN(n) asm volatile("s_waitcnt vmcnt(%0)" :: "i"(n) : "memory")
#define SLOAD_H(Kp, Vp, k0) do { S.st_v0 = load8(ROW(Vp, k0, sr)); S.st_v1 = load8(ROW(Vp, k0, 32 + sr));              \
                         S.st_k0 = load8(ROW(Kp, k0, sr)); S.st_k1 = load8(ROW(Kp, k0, 32 + sr)); } while (0)
#define SWRITE_HK(bf) do { *(bf16x8*)(K_lds + (bf) * SHM_K + kws) = S.st_k0; *(bf16x8*)(K_lds + (bf) * SHM_K + kws + 32 * 256) = S.st_k1; } while (0)
#define SWRITE_HV(bf) do { *(bf16x8*)(V_lds + (bf) * SHM_V + vst0) = S.st_v0; *(bf16x8*)(V_lds + (bf) * SHM_V + vst1) = S.st_v1; } while (0)
#define SWRITE_H(bf) do { SWRITE_HV(bf); SWRITE_HK(bf); } while (0)
DEVI void prime(const BlockRef& cur, char* lds, Seam& S) {
    const int tid = threadIdx.x, wid = __builtin_amdgcn_readfirstlane(tid >> 6), lane = tid & 63, r32 = lane & 31, hi = lane >> 5;
    const int sr = tid >> 4, sc = (tid & 15) * 8, kws = KSWZ(sr, sc * 2); char* K_lds = lds + 2 * SHM_V;
    for (int d0 = 0; d0 < 8; ++d0) S.qr[d0] = load8(cur.Q + (size_t)(cur.qb * QB + wid * QBLK + r32) * DH + d0 * 16 + hi * 8);
    SLOAD_H(cur.K, cur.V, 0); VMW(); SWRITE_HK(0);
    __syncthreads();
}
DEVI void block(const BlockRef& cur, const BlockRef& nxt, char* lds, Seam& S) {
    const int tid = threadIdx.x, wid = __builtin_amdgcn_readfirstlane(tid >> 6), lane = tid & 63, r32 = lane & 31, hi = lane >> 5;
    const int P0 = cur.qb * QB;
    const int NT = (cur.qb + 1) * 4;
    const int qlo = P0 + wid * QBLK, qm = qlo + r32 - 4 * hi;
    char* V_lds = lds; char* K_lds = lds + 2 * SHM_V;
    float* ws = (float*)(lds + 2 * SHM_V + 2 * SHM_K) + wid * 64; float* li_l = ws, * al_l = ws + 32;
    float m_reg = -1e30f, l_reg = 0; f32x16 o[4] = {};
    const int sr = tid >> 4, sc = (tid & 15) * 8, vst0 = v_st(sr, sc), vst1 = v_st(32 + sr, sc), kws = KSWZ(sr, sc * 2);
    const int vb0 = (int)(uintptr_t)V_lds + v_rd_base(lane);
    const bf16_t* Kh = cur.K; const bf16_t* Vh = cur.V;
    unsigned selbits = 1u << cur.qb;
    {
        float v0 = -__builtin_inff(), v1 = v0, v2 = v0; int i0 = 31, i1 = 31, i2 = 31;
        for (int n = 0; n < cur.qb; ++n) {
            const float* kp = cur.ks + n * DH + hi * 8; float g = 0.f;
#pragma unroll
            for (int d0 = 0; d0 < 8; ++d0) { const f32x4 k0 = *(const f32x4*)(kp + d0 * 16), k1 = *(const f32x4*)(kp + d0 * 16 + 4); const bf16x8 q = S.qr[d0];
                g += __uint_as_float(((unsigned)(unsigned short)q[0]) << 16) * k0[0] + __uint_as_float(((unsigned)(unsigned short)q[1]) << 16) * k0[1]
                   + __uint_as_float(((unsigned)(unsigned short)q[2]) << 16) * k0[2] + __uint_as_float(((unsigned)(unsigned short)q[3]) << 16) * k0[3]
                   + __uint_as_float(((unsigned)(unsigned short)q[4]) << 16) * k1[0] + __uint_as_float(((unsigned)(unsigned short)q[5]) << 16) * k1[1]
                   + __uint_as_float(((unsigned)(unsigned short)q[6]) << 16) * k1[2] + __uint_as_float(((unsigned)(unsigned short)q[7]) << 16) * k1[3]; }
            g += __shfl_xor(g, 32);
            if (g > v0) { v2 = v1; i2 = i1; v1 = v0; i1 = i0; v0 = g; i0 = n; }
            else if (g > v1) { v2 = v1; i2 = i1; v1 = g; i1 = n; }
            else if (g > v2) { v2 = g; i2 = n; }
        }
        selbits |= (i0 < 31 ? 1u << i0 : 0u) | (i1 < 31 ? 1u << i1 : 0u) | (i2 < 31 ? 1u << i2 : 0u);
    }
#define BIAS(t) (((selbits >> ((t) >> 2)) & 1u) ? 0.f : -__builtin_inff())
#define RESC(a) do { if (__any((a) < 1.f)) { if (hi == 0) al_l[r32] = (a); asm volatile("s_waitcnt lgkmcnt(0)" ::: "memory");              \
                     for (int d_ = 0; d_ < 4; ++d_) for (int r = 0; r < 16; ++r) o[d_][r] *= al_l[crow(r, hi)]; } } while (0)
#define KBASE(t) ((t) * KVBLK)
#define MASKT(P0_, P1_, t) do { const int kb_ = KBASE(t); if (kb_ + KVBLK - 1 > qlo) mask_tile(P0_, P1_, qm - kb_); } while (0)
    constexpr int NQL = 8;
#define SEAM_K0() do { VMWN(NQL); SWRITE_HK(0); SBAR(); } while (0)
    f32x16 pA0, pA1, pB0, pB1; float mnA, mnB, alA, alB; bf16x8 pa0, pa1, pa2, pa3;
    SWRITE_HV(0); SBAR();
    if (NT > 1) { SLOAD_H(Kh, Vh, KBASE(1)); }
    SBAR(); qkt<0>(pA0, pA1, K_lds, r32, hi, S.qr, BIAS(0));
    MASKT(pA0, pA1, 0); partialSM(pA0, pA1, m_reg, mnA, alA);
    if (NT > 1) { VMW(); SWRITE_H(1); }
    __syncthreads();
#define HALF_STEP(PX0, PX1, mnX, alX, PY0, PY1, alY, t, KB, VB, SB) do {                                                      \
        SBAR(); qkt<KB>(PX0, PX1, K_lds, r32, hi, S.qr, BIAS(t));                                                \
        finishSM(PY0, PY1, alY, l_reg, pa0, pa1, pa2, pa3); SBAR();                                                           \
        if ((t) + 1 < NT) { SLOAD_H(Kh, Vh, KBASE((t) + 1)); SBAR(); }                                                        \
        pv_tile<VB>(o, vb0, pa0, pa1, pa2, pa3); MASKT(PX0, PX1, (t)); partialSM(PX0, PX1, m_reg, mnX, alX);                  \
        __syncthreads();                                                                                                      \
        if ((t) + 1 < NT) { VMW(); SWRITE_H(SB); }                                                                            \
        RESC(alX); __syncthreads(); } while (0)
    for (int t = 1; t + 1 < NT; t += 2) {
        HALF_STEP(pB0, pB1, mnB, alB, pA0, pA1, alA, t, 1, 0, 0);
        HALF_STEP(pA0, pA1, mnA, alA, pB0, pB1, alB, t + 1, 0, 1, 1);
    }
    { SBAR(); qkt<1>(pB0, pB1, K_lds, r32, hi, S.qr, 0.f); SBAR(); }
    SLOAD_H(nxt.K, nxt.V, 0); SBAR();
#pragma unroll
    for (int d0 = 0; d0 < 8; ++d0) S.qr[d0] = load8(nxt.Q + (size_t)(nxt.qb * QB + wid * QBLK + r32) * DH + d0 * 16 + hi * 8);
    SBAR();
    finishSM(pA0, pA1, alA, l_reg, pa0, pa1, pa2, pa3); SBAR();
    pv_tile<0>(o, vb0, pa0, pa1, pa2, pa3);
    { MASKT(pB0, pB1, NT - 1); partialSM(pB0, pB1, m_reg, mnB, alB); __syncthreads(); RESC(alB);
      finishSM(pB0, pB1, alB, l_reg, pa0, pa1, pa2, pa3); SBAR(); pv_tile<1>(o, vb0, pa0, pa1, pa2, pa3); }
    SBAR(); SEAM_K0();
    if (hi == 0) li_l[r32] = l_reg; asm volatile("s_waitcnt lgkmcnt(0)" ::: "memory");
    float rli[16];
#pragma unroll
    for (int r = 0; r < 16; ++r) rli[r] = __builtin_amdgcn_rcpf(li_l[crow(r, hi)]);
    bf16_t* Ow = cur.O + (size_t)(P0 + wid * QBLK) * D;
#pragma unroll
    for (int r = 0; r < 16; ++r) { const int orow = crow(r, hi);
#pragma unroll
        for (int d0 = 0; d0 < 4; ++d0) { const float v = o[d0][r] * rli[r];
            const float vn = __shfl_xor(v, 1);
            if ((r32 & 1) == 0) *(unsigned*)(Ow + (size_t)orow * D + d0 * 32 + r32) = cvtpk(v, vn); } }
    __syncthreads();
#undef BIAS
#undef RESC
#undef KBASE
#undef MASKT
#undef SEAM_K0
#undef HALF_STEP
}
#undef ROW
#undef VMW
#undef VMWN
#undef SLOAD_H
#undef SWRITE_HK
#undef SWRITE_HV
#undef SWRITE_H
DEVI void make_ref(int L, int pass, const bf16_t* Q, const bf16_t* K, const bf16_t* V, bf16_t* O, const float* KSUM, BlockRef& r) {
    const int xcd = L & 7, k = L >> 3, bh = xcd * 4 + (k >> 3), x = k & 7, qb = pass ? (NBLK - 1 - x) : x;
    const int b = bh / NH, h = bh % NH;
    r.Q = Q + (size_t)bh * S * DH; r.K = K + (size_t)bh * S * DH; r.V = V + (size_t)bh * S * DH;
    r.O = O + (size_t)b * S * D + h * DH; r.ks = KSUM + (size_t)bh * NBLK * DH; r.qb = qb;
}
DEVI void attn_phase(char* lds, const bf16_t* Q, const bf16_t* K, const bf16_t* V, bf16_t* O, const float* KSUM, int G, int c) {
    constexpr int total = NB_ * NH * (NBLK / 2);
    int L = c; if (L >= total) return;
    int pass = 0; BlockRef cur; make_ref(L, 0, Q, K, V, O, KSUM, cur);
    Seam S;
    prime(cur, lds, S);
    for (;;) {
        const bool more_pass = pass == 0, more_item = L + G < total, last = !more_pass && !more_item;
        int passn = pass + 1, Ln = L;
        if (!more_pass) { passn = 0; Ln = more_item ? L + G : L; }
        BlockRef nxt = cur; if (!last) make_ref(Ln, passn, Q, K, V, O, KSUM, nxt);
        block(cur, nxt, lds, S);
        if (last) break;
        cur = nxt; pass = passn; L = Ln;
    }
}
#undef KSWZ
#undef SBAR
}


DEVI unsigned f2bf_u(float f) { unsigned u = __float_as_uint(f); return (u + 0x7fffu + ((u >> 16) & 1u)) >> 16; }
DEVI unsigned pk2(float lo, float hi) { return f2bf_u(lo) | (f2bf_u(hi) << 16); }
struct ConvDesc { const float* src; bf16_t* dst; int N, K; };
DEVI void conv_load(const ConvDesc& d, int lane, float (&tv)[32]) {
    const float* p = d.src + (size_t)(lane >> 5) * d.N + (lane & 31);
#pragma unroll
    for (int i = 0; i < 32; ++i) tv[i] = p[(size_t)(2 * i) * d.N];
}
DEVI void conv_store(const ConvDesc& d, int lane, const float (&tv)[32], LAS float* scr) {
#pragma unroll
    for (int i = 0; i < 32; ++i) scr[(2 * i + (lane >> 5)) * 33 + (lane & 31)] = tv[i];
    asm volatile("s_waitcnt lgkmcnt(0)" ::: "memory");
    const int c = lane & 7;
#pragma unroll
    for (int j = 0; j < 4; ++j) { const int n = (lane >> 3) + 8 * j; const LAS float* s = scr + (8 * c) * 33 + n;
        u32x4 o; o.x = pk2(s[0 * 33], s[1 * 33]); o.y = pk2(s[2 * 33], s[3 * 33]); o.z = pk2(s[4 * 33], s[5 * 33]); o.w = pk2(s[6 * 33], s[7 * 33]);
        *(u32x4*)(d.dst + (size_t)n * d.K + 8 * c) = o; }
    asm volatile("s_waitcnt lgkmcnt(0)" ::: "memory");
}
DEVI ConvDesc conv_desc(const float* W, int K, int N, bf16_t* WT, int k0, int n0, int drow0) { ConvDesc d; d.src = W + (size_t)k0 * N + n0; d.dst = WT + (size_t)drow0 * K + k0; d.N = N; d.K = K; return d; }
struct ConvArgs { const float* w_in; const float* w_out; const float* w_qkv; const float* w_o; const float* w1; const float* w3; const float* w2;
                  bf16_t* WT_in; bf16_t* WT_out; bf16_t* WT_qkv; bf16_t* WT_o; bf16_t* W13; bf16_t* W2T; };
constexpr int CI_IN = 16 * 32, CI_OUT = 16 * 64, CI_QKV = 16 * 96, CI_O = 16 * 32, CI_EXP = 768;
constexpr int CONV_LATE = CI_OUT + CI_QKV + CI_O + 2 * NE * CI_EXP;
DEVI ConvDesc conv_desc_late(const ConvArgs& A, int r) {
    if (r < CI_OUT) { const int n0 = 32 * (r % 64), bj = n0 >> 10, j = n0 & 1023; return conv_desc(A.w_out, D, 2 * D, A.WT_out, 64 * (r / 64), n0, 256 * (j >> 7) + 128 * bj + (j & 127)); } r -= CI_OUT;
    if (r < CI_QKV) return conv_desc(A.w_qkv, D, 3 * D, A.WT_qkv, 64 * (r / 96), 32 * (r % 96), 32 * (r % 96)); r -= CI_QKV;
    if (r < CI_O) return conv_desc(A.w_o, D, D, A.WT_o, 64 * (r / 32), 32 * (r % 32), 32 * (r % 32)); r -= CI_O;
    const int le = r / CI_EXP; r -= le * CI_EXP;
    if (r < 256) { const int n0 = 32 * (r % 16); return conv_desc(A.w1 + (size_t)le * D * FF, D, FF, A.W13 + (size_t)le * 1024 * D, 64 * (r / 16), n0, 256 * (n0 >> 7) + (n0 & 127)); } r -= 256;
    if (r < 256) { const int n0 = 32 * (r % 16); return conv_desc(A.w3 + (size_t)le * D * FF, D, FF, A.W13 + (size_t)le * 1024 * D, 64 * (r / 16), n0, 256 * (n0 >> 7) + 128 + (n0 & 127)); } r -= 256;
    return conv_desc(A.w2 + (size_t)le * FF * D, FF, D, A.W2T + (size_t)le * 1024 * FF, 64 * (r / 32), 32 * (r % 32), 32 * (r % 32));
}
namespace ssm {
typedef float f32x16 __attribute__((ext_vector_type(16)));
constexpr int XS_STRIDE = 272, XS_IMG = 16 * XS_STRIDE;
constexpr int WAVE_LDS = 2 * XS_IMG + 2048;
constexpr int CONV_SCR = 8448;
constexpr int SSM_OFF = 8 * CONV_SCR, SEG_OFF = SSM_OFF + 4 * WAVE_LDS;
DEVI void ssm_abar(const float* lam_re, const float* lam_im, const float* log_dt, int g, int p, float& ar, float& ai, float& gr, float& gi) {
    const float dt = expf(log_dt[g]);
    const float lr = fminf(lam_re[g * SP + p], -1e-4f), li = lam_im[g * SP + p];
    const float mag = expf(lr * dt); ar = mag * cosf(li * dt); ai = mag * sinf(li * dt);
    const float den = lr * lr + li * li, nr = ar - 1.f;
    gr = (nr * lr + ai * li) / den; gi = (ai * lr - nr * li) / den;
}
DEVI void build_tables(int chunk, const float* lam_re, const float* lam_im, const float* log_dt, const float* b_re, const float* b_im, const float* c_re, const float* c_im, bf16_t* BBT, bf16_t* CT) {
    if (chunk < SG * 4 * 64) {
        const int g = chunk >> 8, cb = (chunk >> 6) & 3, l = chunk & 63, p = 32 * (cb >> 1) + (l & 31), im = cb & 1;
        float ar, ai, gr, gi; ssm_abar(lam_re, lam_im, log_dt, g, p, ar, ai, gr, gi);
        unsigned w[4];
#pragma unroll
        for (int j = 0; j < 8; j += 2) { float v[2];
#pragma unroll
            for (int q = 0; q < 2; ++q) { const int c = 8 * (l >> 5) + j + q; const float br = b_re[(g * SP + p) * SC + c], bi = b_im[(g * SP + p) * SC + c]; v[q] = im ? (gr * bi + gi * br) : (gr * br - gi * bi); }
            w[j >> 1] = (unsigned)f2bf(v[0]) | ((unsigned)f2bf(v[1]) << 16); }
        *(u32x4*)(BBT + (size_t)chunk * 8) = (u32x4){w[0], w[1], w[2], w[3]};
    } else {
        const int ch2 = chunk - SG * 4 * 64, g = ch2 >> 8, ks = (ch2 >> 6) & 3, l = ch2 & 63, chn = l & 15;
        unsigned w[4];
#pragma unroll
        for (int j = 0; j < 8; j += 2) { float v[2];
#pragma unroll
            for (int q = 0; q < 2; ++q) { const int k = ks * 32 + 8 * (l >> 4) + j + q, sx = k & 3, p = 32 * (sx >> 1) + (k >> 2); v[q] = (sx & 1) ? -c_im[((size_t)g * SC + chn) * SP + p] : c_re[((size_t)g * SC + chn) * SP + p]; }
            w[j >> 1] = (unsigned)f2bf(v[0]) | ((unsigned)f2bf(v[1]) << 16); }
        *(u32x4*)(CT + (size_t)ch2 * 8) = (u32x4){w[0], w[1], w[2], w[3]};
    }
}
DEVI float gelu_fast(float x) { const float z = 1.5957691216057308f * (x + 0.044715f * x * x * x); return x * __builtin_amdgcn_rcpf(1.f + __expf(-z)); }
template <bool OUT>
DEVI void segment(LAS unsigned char* wl, const float* Ub, bf16_t* Zb, int base0, int base1, int lane, float a0r, float a0i, float a1r, float a1i,
                  float& x0r, float& x0i, float& x1r, float& x1i, const bf16x8 (&bbt)[4], const bf16x8 (&ct)[4], float dsk) {
    const int r32 = lane & 31, hi = lane >> 5;
    const int hm = (r32 >> 2) & 1, rm = (r32 & 3) + 4 * (r32 >> 3);
    const float* urow = Ub + (size_t)((hm ? base1 : base0) + rm) * SC + 8 * hi;
    LAS unsigned char* xs = wl + hi * XS_IMG; LAS float* ut = (LAS float*)(wl + 2 * XS_IMG);
    f32x4 n0 = *(const f32x4*)urow, n1 = *(const f32x4*)(urow + 4);
#pragma nounroll
    for (int g = 0; g < 32; ++g) {
        const f32x4 u0 = n0, u1 = n1;
        { const int gn = g + 1 < 32 ? g + 1 : g; const float* up = urow + (size_t)gn * 16 * SC; n0 = *(const f32x4*)up; n1 = *(const f32x4*)(up + 4); }
        if (OUT) { *(LAS f32x4*)(ut + r32 * 16 + 8 * hi) = u0; *(LAS f32x4*)(ut + r32 * 16 + 8 * hi + 4) = u1; }
        u32x4 aw = {cvt_pk_bf16(u0[0], u0[1]), cvt_pk_bf16(u0[2], u0[3]), cvt_pk_bf16(u1[0], u1[1]), cvt_pk_bf16(u1[2], u1[3])};
        const bf16x8 afrag = *reinterpret_cast<bf16x8*>(&aw);
        f32x16 d[4];
#pragma unroll
        for (int cb = 0; cb < 4; ++cb) { d[cb] = f32x16{}; d[cb] = __builtin_amdgcn_mfma_f32_32x32x16_bf16(afrag, bbt[cb], d[cb], 0, 0, 0); }
#pragma unroll
        for (int r = 0; r < 16; ++r) {
            const float n0r = fmaf(a0r, x0r, fmaf(-a0i, x0i, d[0][r])), n0i = fmaf(a0r, x0i, fmaf(a0i, x0r, d[1][r]));
            const float n1r = fmaf(a1r, x1r, fmaf(-a1i, x1i, d[2][r])), n1i = fmaf(a1r, x1i, fmaf(a1i, x1r, d[3][r]));
            x0r = n0r; x0i = n0i; x1r = n1r; x1i = n1i;
            if (OUT) *(LAS u32x2*)(xs + r * XS_STRIDE + r32 * 8) = (u32x2){cvt_pk_bf16(x0r, x0i), cvt_pk_bf16(x1r, x1i)};
        }
        if (OUT) {
#pragma unroll
            for (int st = 0; st < 2; ++st) {
                f32x4 acc = {0.f, 0.f, 0.f, 0.f};
#pragma unroll
                for (int ks = 0; ks < 4; ++ks) { const bf16x8 xa = *(const LAS bf16x8*)(wl + st * XS_IMG + (lane & 15) * XS_STRIDE + ks * 64 + 16 * (lane >> 4));
                    acc = __builtin_amdgcn_mfma_f32_16x16x32_bf16(xa, ct[ks], acc, 0, 0, 0); }
#pragma unroll
                for (int r = 0; r < 4; ++r) { const int t = 4 * (lane >> 4) + r, mrow = (t & 3) + 8 * (t >> 2) + 4 * st; const float uv = ut[mrow * 16 + (lane & 15)];
                    Zb[(size_t)((st ? base1 : base0) + g * 16 + t) * SC + (lane & 15)] = f2bf(gelu_fast(acc[r] + dsk * uv)); }
            }
        }
    }
}
DEVI void ssm_phase(LAS unsigned char* lds, volatile LAS unsigned* MISC, const float* U, bf16_t* Z, const bf16_t* BBT, const bf16_t* CT, const float* lam_re, const float* lam_im, const float* log_dt, const float* d_skip,
                    const ConvArgs& CA, int G, int c) {
    const int tid = threadIdx.x, lane = tid & 63, wave = __builtin_amdgcn_readfirstlane(tid >> 6);
    LAS unsigned* segctr = (LAS unsigned*)(MISC + 16); LAS unsigned* itemctr = (LAS unsigned*)(MISC + 17);
    if (wave < 4) {
        LAS unsigned char* wl = lds + SSM_OFF + wave * WAVE_LDS;
        LAS f32x2* seg = (LAS f32x2*)(lds + SEG_OFF);
        const int r32 = lane & 31, hi = lane >> 5;
        unsigned round = 0;
        for (int unit = c; unit < NB_ * SG; unit += G) {
            const int g = unit & (SG - 1);
            float a0r, a0i, a1r, a1i, gr, gi; ssm_abar(lam_re, lam_im, log_dt, g, r32, a0r, a0i, gr, gi); ssm_abar(lam_re, lam_im, log_dt, g, 32 + r32, a1r, a1i, gr, gi);
            float p0r = a0r, p0i = a0i, p1r = a1r, p1i = a1i;
#pragma unroll
            for (int q = 0; q < 9; ++q) { const float t0 = p0r * p0r - p0i * p0i, t1 = 2.f * p0r * p0i; p0r = t0; p0i = t1; const float t2 = p1r * p1r - p1i * p1i, t3 = 2.f * p1r * p1i; p1r = t2; p1i = t3; }
            bf16x8 bbt[4], ct[4];
#pragma unroll
            for (int q = 0; q < 4; ++q) { bbt[q] = *(const bf16x8*)(BBT + ((size_t)(g * 4 + q) * 64 + lane) * 8); ct[q] = *(const bf16x8*)(CT + ((size_t)(g * 4 + q) * 64 + lane) * 8); }
            const float dsk = d_skip[g * SC + (lane & 15)];
            const float* Ub = U + (size_t)unit * S * SC; bf16_t* Zb = Z + (size_t)unit * S * SC;
            const int base0 = wave * 1024, base1 = base0 + 512, strm = 2 * wave + hi;
            float x0r = 0.f, x0i = 0.f, x1r = 0.f, x1i = 0.f;
            segment<false>(wl, Ub, Zb, base0, base1, lane, a0r, a0i, a1r, a1i, x0r, x0i, x1r, x1i, bbt, ct, dsk);
            seg[strm * 64 + r32] = (f32x2){x0r, x0i}; seg[strm * 64 + 32 + r32] = (f32x2){x1r, x1i};
            asm volatile("s_waitcnt lgkmcnt(0)" ::: "memory");
            ++round;
            if (lane == 0) __hip_atomic_fetch_add(segctr, 1u, __ATOMIC_RELAXED, __HIP_MEMORY_SCOPE_WORKGROUP);
            while (__hip_atomic_load(segctr, __ATOMIC_RELAXED, __HIP_MEMORY_SCOPE_WORKGROUP) < 8u * round - 4u) __builtin_amdgcn_s_sleep(1);
            asm volatile("" ::: "memory");
            x0r = 0.f; x0i = 0.f; x1r = 0.f; x1i = 0.f;
#pragma unroll
            for (int v = 0; v < 7; ++v) { if (v < strm) { const f32x2 e0 = seg[v * 64 + r32], e1 = seg[v * 64 + 32 + r32];
                const float t0 = p0r * x0r - p0i * x0i + e0[0], t1 = p0r * x0i + p0i * x0r + e0[1]; x0r = t0; x0i = t1;
                const float t2 = p1r * x1r - p1i * x1i + e1[0], t3 = p1r * x1i + p1i * x1r + e1[1]; x1r = t2; x1i = t3; } }
            asm volatile("s_waitcnt lgkmcnt(0)" ::: "memory");
            if (lane == 0) __hip_atomic_fetch_add(segctr, 1u, __ATOMIC_RELAXED, __HIP_MEMORY_SCOPE_WORKGROUP);
            segment<true>(wl, Ub, Zb, base0, base1, lane, a0r, a0i, a1r, a1i, x0r, x0i, x1r, x1i, bbt, ct, dsk);
            while (__hip_atomic_load(segctr, __ATOMIC_RELAXED, __HIP_MEMORY_SCOPE_WORKGROUP) < 8u * round) __builtin_amdgcn_s_sleep(1);
        }
    }
    LAS float* scr = (LAS float*)(lds + wave * CONV_SCR);
    auto pull = [&](ConvDesc& d) -> bool {
        unsigned j = 0; if (lane == 0) j = __hip_atomic_fetch_add(itemctr, 1u, __ATOMIC_RELAXED, __HIP_MEMORY_SCOPE_WORKGROUP);
        j = (unsigned)__builtin_amdgcn_readfirstlane((int)j);
        const long it = (long)c + (long)G * j; if (it >= CONV_LATE) return false;
        d = conv_desc_late(CA, (int)it); return true; };
    ConvDesc d0; float t0[32];
    bool v0 = pull(d0); if (v0) conv_load(d0, lane, t0);
    while (v0) {
        ConvDesc d1 = d0; float t1[32]; const bool v1 = pull(d1);
        if (v1) conv_load(d1, lane, t1);
        conv_store(d0, lane, t0, scr);
        d0 = d1; v0 = v1;
#pragma unroll
        for (int i = 0; i < 32; ++i) t0[i] = t1[i];
    }
}
}

namespace route {
constexpr int T_REC = 0, T_RANK = 1024, T_BASE = 1536, T_LOG = 2048;
DEVI void route_phase(LAS unsigned char* lds, LAS unsigned char* tab, const float* H, const float* gain, bf16_t* XN, const float* w_group, const float* w_expert,
                      Slot* slot, unsigned* cnt, int* row_token, int G, int c) {
    const int tid = threadIdx.x, lane = tid & 63, wave = __builtin_amdgcn_readfirstlane(tid >> 6);
    LAS float* xs = (LAS float*)(lds + wave * 16384);
    LAS float* lgs = (LAS float*)(tab + T_LOG + wave * 640);
    LAS int* rec = (LAS int*)(tab + T_REC); LAS int* rank = (LAS int*)(tab + T_RANK); LAS int* basee = (LAS int*)(tab + T_BASE);
    const int kk = lane >> 3, q = lane & 7;
    for (int base = c * 64; base < NTOK; base += G * 64) {
#pragma nounroll
        for (int grp = 0; grp < 2; ++grp) {
            const int tok0 = base + wave * 8 + grp * 4;
            f32x4 v[4][4]; float rstd[4];
#pragma unroll
            for (int t = 0; t < 4; ++t)
#pragma unroll
                for (int j = 0; j < 4; ++j) v[t][j] = *(const f32x4*)(H + (size_t)(tok0 + t) * D + 4 * lane + 256 * j);
#pragma unroll
            for (int t = 0; t < 4; ++t) { float ss = 0.f;
#pragma unroll
                for (int j = 0; j < 4; ++j) ss += v[t][j][0] * v[t][j][0] + v[t][j][1] * v[t][j][1] + v[t][j][2] * v[t][j][2] + v[t][j][3] * v[t][j][3];
                rstd[t] = rsqrtf(wave_sum(ss) * (1.f / D) + EPS); }
#pragma unroll
            for (int j = 0; j < 4; ++j) { const f32x4 gg = *(const f32x4*)(gain + 4 * lane + 256 * j);
#pragma unroll
                for (int t = 0; t < 4; ++t) { v[t][j] = v[t][j] * gg * rstd[t];
                    u32x2 w; w.x = cvt_pk_bf16(v[t][j][0], v[t][j][1]); w.y = cvt_pk_bf16(v[t][j][2], v[t][j][3]);
                    *(u32x2*)(XN + (size_t)(tok0 + t) * D + 4 * lane + 256 * j) = w; }
#pragma unroll
                for (int i = 0; i < 4; ++i) *(LAS f32x4*)(xs + (size_t)(4 * lane + 256 * j + i) * 4) = (f32x4){v[0][j][i], v[1][j][i], v[2][j][i], v[3][j][i]}; }
            asm volatile("s_waitcnt lgkmcnt(0)" ::: "memory");
            float ae[4][4], ag[4][4];
#pragma unroll
            for (int t = 0; t < 4; ++t)
#pragma unroll
                for (int i = 0; i < 4; ++i) { ae[t][i] = 0.f; ag[t][i] = 0.f; }
#pragma unroll 8
            for (int i = 0; i < 128; ++i) { const int k = 8 * i + kk;
                const f32x4 w = *(const f32x4*)(w_expert + (size_t)k * NE + 4 * q); const f32x4 x = *(const LAS f32x4*)(xs + k * 4);
#pragma unroll
                for (int t = 0; t < 4; ++t)
#pragma unroll
                    for (int o = 0; o < 4; ++o) ae[t][o] += x[t] * w[o]; }
#pragma unroll 8
            for (int i = 0; i < 16; ++i) { const int k = 64 * i + lane;
                const f32x4 w = *(const f32x4*)(w_group + (size_t)k * NGRP); const f32x4 x = *(const LAS f32x4*)(xs + k * 4);
#pragma unroll
                for (int t = 0; t < 4; ++t)
#pragma unroll
                    for (int o = 0; o < 4; ++o) ag[t][o] += x[t] * w[o]; }
#pragma unroll
            for (int t = 0; t < 4; ++t)
#pragma unroll
                for (int o = 0; o < 4; ++o) { float a = ae[t][o]; a += __shfl_xor(a, 8); a += __shfl_xor(a, 16); a += __shfl_xor(a, 32); ae[t][o] = a; ag[t][o] = wave_sum(ag[t][o]); }
            if (lane < 8) {
#pragma unroll
                for (int t = 0; t < 4; ++t) *(LAS f32x4*)(lgs + t * 40 + 4 * q) = (f32x4){ae[t][0], ae[t][1], ae[t][2], ae[t][3]}; }
            if (lane == 0) {
#pragma unroll
                for (int t = 0; t < 4; ++t) *(LAS f32x4*)(lgs + t * 40 + 32) = (f32x4){ag[t][0], ag[t][1], ag[t][2], ag[t][3]}; }
            asm volatile("s_waitcnt lgkmcnt(0)" ::: "memory");
            if (lane < 4) {
                const LAS float* L = lgs + lane * 40;
                int gi = 0; float gm = L[32];
#pragma unroll
                for (int i = 1; i < NGRP; ++i) { const float t = L[32 + i]; if (t > gm) { gm = t; gi = i; } }
                float gs = 0.f;
#pragma unroll
                for (int i = 0; i < NGRP; ++i) gs += __expf(L[32 + i] - gm);
                const float g_gate = 1.f / gs;
                int i0 = 0; float m0 = L[gi * EPG];
#pragma unroll
                for (int i = 1; i < EPG; ++i) { const float t = L[gi * EPG + i]; if (t > m0) { m0 = t; i0 = i; } }
                int i1 = -1; float m1 = -3.0e38f;
#pragma unroll
                for (int i = 0; i < EPG; ++i) { const float t = L[gi * EPG + i]; if (i != i0 && t > m1) { m1 = t; i1 = i; } }
                const float p1 = __expf(m1 - m0);
                const float g0 = g_gate / (1.f + p1), g1 = g_gate * p1 / (1.f + p1);
                const int sidx = (wave * 8 + grp * 4 + lane) * 2;
                rec[sidx * 2 + 0] = gi * EPG + i0; rec[sidx * 2 + 1] = (int)__float_as_uint(g0);
                rec[sidx * 2 + 2] = gi * EPG + i1; rec[sidx * 2 + 3] = (int)__float_as_uint(g1);
            }
            asm volatile("s_waitcnt lgkmcnt(0)" ::: "memory");
        }
        __syncthreads();
        if (tid < NE) {
            int n = 0;
            for (int sidx = 0; sidx < 128; ++sidx) { if (rec[sidx * 2] == tid) { rank[sidx] = n; ++n; } }
            basee[tid] = n ? (int)atomicAdd(&cnt[tid], (unsigned)n) : 0;
        }
        __syncthreads();
        if (tid < 128) {
            const int e = rec[tid * 2], pos = basee[e] + rank[tid], tok = base + (tid >> 1);
            Slot sl; sl.epos = e * ECAP + pos; sl.gate = __uint_as_float((unsigned)rec[tid * 2 + 1]);
            slot[tok * 2 + (tid & 1)] = sl; row_token[e * ECAP + pos] = tok;
        }
        __syncthreads();
    }
}
}

enum { PH_PRO = 0, PH_WIN, PH_SSM, PH_WOUT, PH_ROUTE0, PH_MOE1_0, PH_MOE2_0, PH_COMB0, PH_QKV, PH_ATTN, PH_WO, PH_ROUTE1, PH_MOE1_1, PH_MOE2_1, PH_FINAL, PH_COUNT };
#ifndef PROBE_DUP
#define PROBE_DUP (-1)
#endif
#ifndef PROBE_DUP2
#define PROBE_DUP2 (-1)
#endif
struct MegaArgs { const float* in[21]; float* out; unsigned char* ws; int ph_lo, ph_hi, li, pad; };

__global__ void __launch_bounds__(NTHR, 2) mega(MegaArgs a) {
    extern __shared__ __attribute__((aligned(16))) unsigned char lds_raw[];
    LAS unsigned char* lds = (LAS unsigned char*)lds_raw;
    volatile LAS unsigned* MISC = (volatile LAS unsigned*)(lds + LDS_MISC);
    LAS int* tabI = (LAS int*)(lds + LDS_TAB);
    const int tid = threadIdx.x, lane = tid & 63, wave = __builtin_amdgcn_readfirstlane(tid >> 6);
    const int G = gridDim.x, bx = blockIdx.x;
    unsigned char* ws = a.ws;
    unsigned* ctl = (unsigned*)(ws + WS_CTL);
    bf16_t* WT_in = (bf16_t*)(ws + WS_WD); bf16_t* WT_out = WT_in + (size_t)D * D; bf16_t* WT_qkv = WT_out + (size_t)2 * D * D; bf16_t* WT_o = WT_qkv + (size_t)3 * D * D;
    bf16_t* W13 = (bf16_t*)(ws + WS_W13); bf16_t* W2T = (bf16_t*)(ws + WS_W2);
    bf16_t* XN = (bf16_t*)(ws + WS_XN); float* H = (float*)(ws + WS_H);
    float* U = (float*)(ws + WS_U); bf16_t* Z = (bf16_t*)(ws + WS_Z);
    bf16_t* Q = (bf16_t*)(ws + WS_Q); bf16_t* O = (bf16_t*)(ws + WS_O);
    bf16_t* ACT = (bf16_t*)(ws + WS_ACT); bf16_t* Y = (bf16_t*)(ws + WS_Y);
    float* KSUM = (float*)(ws + WS_CTL + CTL_KSUM);
    int* rtok = (int*)(ws + WS_RTOK); Slot* slot = (Slot*)(ws + WS_SLOT);
    bf16_t* BBT = (bf16_t*)(ws + WS_TAB2); bf16_t* CTt = BBT + (size_t)SG * 4 * 64 * 8;
    const int gwv = bx * NWAVES + wave, NGWV = G * NWAVES;
    if (tid < 32) MISC[tid] = 0u;
    __syncthreads();
    XcdBarrier bar = xcd_barrier_post(ctl + CW_BAR + a.li * XCD_BAR_WORDS, MISC + 8);
    const int lo = a.ph_lo, hi = a.ph_hi;
#define IN(k) (lo <= (k) && (k) < hi)
#define SEAM(k) do { if (IN(k) && IN((k) + 1)) xcd_barrier(bar); } while (0)

    if (IN(PH_PRO)) { _Pragma("nounroll") for (int rep_ = 0; rep_ < (PROBE_DUP == PH_PRO ? 2 : 1); ++rep_) {
        if (rep_) xcd_barrier(bar);
        LAS float* scr = (LAS float*)(lds + wave * 16384);
        for (int it = gwv; it < CI_IN; it += NGWV) { const ConvDesc cd = conv_desc(a.in[4], D, D, WT_in, 64 * (it / 32), 32 * (it % 32), 32 * (it % 32)); float tv[32]; conv_load(cd, lane, tv); conv_store(cd, lane, tv, scr); }
        for (int ch = bx * NTHR + tid; ch < 2 * SG * 4 * 64; ch += G * NTHR) ssm::build_tables(ch, a.in[5], a.in[6], a.in[7], a.in[8], a.in[9], a.in[10], a.in[11], BBT, CTt);
        for (int tok = gwv; tok < NTOK; tok += NGWV) tok_row<true, false, false, false>(tok, lane, a.in[0], nullptr, a.in[1], XN, nullptr, nullptr, nullptr, nullptr, nullptr, nullptr, nullptr, nullptr, nullptr);
    } }
    SEAM(PH_PRO);
    if (IN(PH_WIN)) { _Pragma("nounroll") for (int rep_ = 0; rep_ < (PROBE_DUP == PH_WIN || PROBE_DUP2 == PH_WIN ? 2 : 1); ++rep_) { if (rep_) xcd_barrier(bar); { PWin P{XN, WT_in, U, D, G, bx}; pg8::gemm_phase(lds, P); } } }
    SEAM(PH_WIN);
    if (IN(PH_SSM)) { _Pragma("nounroll") for (int rep_ = 0; rep_ < (PROBE_DUP == PH_SSM || PROBE_DUP2 == PH_SSM ? 2 : 1); ++rep_) { if (rep_) xcd_barrier(bar); { const ConvArgs CA{a.in[4], a.in[13], a.in[14], a.in[15], a.in[18], a.in[19], a.in[20], WT_in, WT_out, WT_qkv, WT_o, W13, W2T}; ssm::ssm_phase(lds, MISC, U, Z, BBT, CTt, a.in[5], a.in[6], a.in[7], a.in[12], CA, G, bx); } } }
    SEAM(PH_SSM);
    if (IN(PH_WOUT)) { _Pragma("nounroll") for (int rep_ = 0; rep_ < (PROBE_DUP == PH_WOUT || PROBE_DUP2 == PH_WOUT ? 2 : 1); ++rep_) { if (rep_) xcd_barrier(bar); { PWout P{Z, WT_out, a.in[0], H, D, G, bx}; pg8::gemm_phase(lds, P); } } }
    SEAM(PH_WOUT);
    if (IN(PH_ROUTE0)) { { route::route_phase(lds, lds + LDS_TAB, H, a.in[2], XN, a.in[16], a.in[17], slot, ctl + CW_COUNT, rtok, G, bx); } if (PROBE_DUP == PH_ROUTE0) { xcd_barrier(bar); { route::route_phase(lds, lds + LDS_TAB, H, a.in[2], XN, a.in[16], a.in[17], (Slot*)(ws + WS_O), ctl + 128, (int*)(ws + WS_O + 4 * MiB), G, bx); } } }
    SEAM(PH_ROUTE0);
    if (IN(PH_MOE1_0)) { _Pragma("nounroll") for (int rep_ = 0; rep_ < (PROBE_DUP == PH_MOE1_0 || PROBE_DUP2 == PH_MOE1_0 ? 2 : 1); ++rep_) { if (rep_) xcd_barrier(bar); { moe_plan(tabI, ctl + CW_COUNT, rtok, G, bx, true); PMoe1 P{XN, W13, ACT, tabI, D, G, bx}; pg8::gemm_phase(lds, P); } } }
    SEAM(PH_MOE1_0);
    if (IN(PH_MOE2_0)) { _Pragma("nounroll") for (int rep_ = 0; rep_ < (PROBE_DUP == PH_MOE2_0 || PROBE_DUP2 == PH_MOE2_0 ? 2 : 1); ++rep_) { if (rep_) xcd_barrier(bar); { moe_plan(tabI, ctl + CW_COUNT, rtok, G, bx, false); PMoe2 P{ACT, W2T, Y, tabI, FF, G, bx}; pg8::gemm_phase(lds, P); } } }
    SEAM(PH_MOE2_0);
    if (IN(PH_COMB0)) { _Pragma("nounroll") for (int rep_ = 0; rep_ < (PROBE_DUP == PH_COMB0 || PROBE_DUP2 == PH_COMB0 ? 2 : 1); ++rep_) { if (rep_) xcd_barrier(bar); { for (int tok = gwv; tok < NTOK; tok += NGWV) tok_row<false, true, false, false>(tok, lane, nullptr, H, a.in[1] + D, XN, nullptr, Y, slot, ctl + CW_COUNT, nullptr, nullptr, nullptr, nullptr, nullptr); } } }
    SEAM(PH_COMB0);
    if (IN(PH_QKV)) { _Pragma("nounroll") for (int rep_ = 0; rep_ < (PROBE_DUP == PH_QKV || PROBE_DUP2 == PH_QKV ? 2 : 1); ++rep_) { if (rep_) xcd_barrier(bar); { PQkv P{XN, WT_qkv, Q, KSUM, D, G, bx}; pg8::gemm_phase(lds, P); } } }
    SEAM(PH_QKV);
    if (IN(PH_ATTN)) { _Pragma("nounroll") for (int rep_ = 0; rep_ < (PROBE_DUP == PH_ATTN || PROBE_DUP2 == PH_ATTN ? 2 : 1); ++rep_) { if (rep_) xcd_barrier(bar); attn::attn_phase((char*)lds_raw, Q, Q + (size_t)NTOK * D, Q + (size_t)2 * NTOK * D, O, KSUM, G, bx); } }
    SEAM(PH_ATTN);
    if (IN(PH_WO)) { _Pragma("nounroll") for (int rep_ = 0; rep_ < (PROBE_DUP == PH_WO || PROBE_DUP2 == PH_WO ? 2 : 1); ++rep_) { if (rep_) xcd_barrier(bar); { PWo P{O, WT_o, H, D, G, bx}; pg8::gemm_phase(lds, P); } } }
    SEAM(PH_WO);
    if (IN(PH_ROUTE1)) { _Pragma("nounroll") for (int rep_ = 0; rep_ < (PROBE_DUP == PH_ROUTE1 || PROBE_DUP2 == PH_ROUTE1 ? 2 : 1); ++rep_) { if (rep_) xcd_barrier(bar); { route::route_phase(lds, lds + LDS_TAB, H, a.in[2] + D, XN, a.in[16] + (size_t)D * NGRP, a.in[17] + (size_t)D * NE, slot, ctl + CW_COUNT + 32, rtok, G, bx); } } }
    SEAM(PH_ROUTE1);
    if (IN(PH_MOE1_1)) { _Pragma("nounroll") for (int rep_ = 0; rep_ < (PROBE_DUP == PH_MOE1_1 || PROBE_DUP2 == PH_MOE1_1 ? 2 : 1); ++rep_) { if (rep_) xcd_barrier(bar); { moe_plan(tabI, ctl + CW_COUNT + 32, rtok, G, bx, true); PMoe1 P{XN, W13 + (size_t)NE * 1024 * D, ACT, tabI, D, G, bx}; pg8::gemm_phase(lds, P); } } }
    SEAM(PH_MOE1_1);
    if (IN(PH_MOE2_1)) { _Pragma("nounroll") for (int rep_ = 0; rep_ < (PROBE_DUP == PH_MOE2_1 || PROBE_DUP2 == PH_MOE2_1 ? 2 : 1); ++rep_) { if (rep_) xcd_barrier(bar); { moe_plan(tabI, ctl + CW_COUNT + 32, rtok, G, bx, false); PMoe2 P{ACT, W2T + (size_t)NE * 1024 * FF, Y, tabI, FF, G, bx}; pg8::gemm_phase(lds, P); } } }
    SEAM(PH_MOE2_1);
    if (IN(PH_FINAL)) { _Pragma("nounroll") for (int rep_ = 0; rep_ < (PROBE_DUP == PH_FINAL || PROBE_DUP2 == PH_FINAL ? 2 : 1); ++rep_) { if (rep_) xcd_barrier(bar); { for (int tok = gwv; tok < NTOK; tok += NGWV) tok_row<false, true, false, true>(tok, lane, nullptr, H, a.in[3], nullptr, a.out, Y, slot, ctl + CW_COUNT + 32, nullptr, nullptr, nullptr, nullptr, nullptr); } } }
#undef IN
#undef SEAM
}

#ifndef ONE_LAUNCH
#define ONE_LAUNCH 1
#endif
#ifndef FASTMASK
#define FASTMASK ((1u << PH_PRO) | (1u << PH_WIN) | (1u << PH_WOUT) | (1u << PH_QKV) | (1u << PH_WO) | (1u << PH_MOE1_0) | (1u << PH_MOE2_0) | (1u << PH_MOE1_1) | (1u << PH_MOE2_1) | (1u << PH_ATTN) | (1u << PH_SSM))
#endif
extern "C" void kernel_launch(void* const* d_in, const int* in_sizes, int n_in, void* d_out, int out_size, void* d_ws, size_t ws_size, hipStream_t stream) {
    if (n_in != 21 || in_sizes[0] != NTOK * D || out_size != NTOK * D || ws_size < WS_END) {
        fprintf(stderr, "kernel_launch: unexpected shapes (n_in %d, in0 %d, out %d, ws %zu)\n", n_in, n_in > 0 ? in_sizes[0] : -1, out_size, ws_size); return; }
    static int grid = 0;
    if (grid == 0) {
        int dev = 0, cus = 0;
        if (hipGetDevice(&dev) != hipSuccess || hipDeviceGetAttribute(&cus, hipDeviceAttributeMultiprocessorCount, dev) != hipSuccess || cus <= 0) cus = 256;
        if (hipFuncSetAttribute((const void*)mega, hipFuncAttributeMaxDynamicSharedMemorySize, LDS_BYTES) != hipSuccess) fprintf(stderr, "kernel_launch: hipFuncSetAttribute failed\n");
        int per_cu = 0; (void)hipOccupancyMaxActiveBlocksPerMultiprocessor(&per_cu, (const void*)mega, NTHR, LDS_BYTES); (void)hipGetLastError();
        if (per_cu < 1) fprintf(stderr, "kernel_launch: occupancy query says %d blocks per CU\n", per_cu);
        grid = cus;
    }
    const float* x = (const float*)d_in[0]; const float* ln_mix = (const float*)d_in[1]; const float* ln_ffn = (const float*)d_in[2]; const float* ln_final = (const float*)d_in[3];
    const float* w_in = (const float*)d_in[4]; const float* lam_re = (const float*)d_in[5]; const float* lam_im = (const float*)d_in[6]; const float* log_dt = (const float*)d_in[7];
    const float* b_re = (const float*)d_in[8]; const float* b_im = (const float*)d_in[9]; const float* c_re = (const float*)d_in[10]; const float* c_im = (const float*)d_in[11];
    const float* ssm_d = (const float*)d_in[12]; const float* w_out = (const float*)d_in[13]; const float* w_qkv = (const float*)d_in[14]; const float* w_o = (const float*)d_in[15];
    const float* w_group = (const float*)d_in[16]; const float* w_expert = (const float*)d_in[17]; const float* w1 = (const float*)d_in[18]; const float* w3 = (const float*)d_in[19]; const float* w2 = (const float*)d_in[20];
    unsigned char* ws = (unsigned char*)d_ws; float* out = (float*)d_out;
    unsigned* ctl = (unsigned*)(ws + WS_CTL); float* KSUM = (float*)(ws + WS_CTL + CTL_KSUM); float* tab = (float*)(ws + WS_TAB);
    Slot* slot = (Slot*)(ws + WS_SLOT); int* rtok = (int*)(ws + WS_RTOK);
    bf16_t* XN = (bf16_t*)(ws + WS_XN); float* H = (float*)(ws + WS_H);
    float* U = (float*)(ws + WS_U); bf16_t* Z = (bf16_t*)(ws + WS_Z);
    bf16_t* Q = (bf16_t*)(ws + WS_Q); bf16_t* Kb = (bf16_t*)(ws + WS_K); bf16_t* Vb = (bf16_t*)(ws + WS_V); bf16_t* O = (bf16_t*)(ws + WS_O);
    bf16_t* ACT = (bf16_t*)(ws + WS_ACT); bf16_t* Y = (bf16_t*)(ws + WS_Y);
    (void)hipMemsetAsync(ws + WS_CTL, 0, CTL_BYTES, stream);
    MegaArgs ma{};
    for (int i = 0; i < 21; ++i) ma.in[i] = (const float*)d_in[i];
    ma.out = out; ma.ws = ws;
    int li = 0;
    auto fast = [&](int ph) { return (FASTMASK >> ph) & 1u; };
    auto mega_launch = [&](int lo, int hi) { ma.ph_lo = lo; ma.ph_hi = hi; ma.li = li++; ma.pad = 0; hipLaunchKernelGGL(mega, dim3(grid), dim3(NTHR), LDS_BYTES, stream, ma); };
#if ONE_LAUNCH
    mega_launch(0, PH_COUNT);
    return;
#endif
    if (fast(PH_PRO)) mega_launch(PH_PRO, PH_PRO + 1);
    k_ssm_params<<<SG, SP, 0, stream>>>(lam_re, lam_im, log_dt, b_re, b_im, tab);
    k_tok<true, false, false, false><<<NTOK / 4, 256, 0, stream>>>(x, nullptr, ln_mix, XN, nullptr, nullptr, nullptr, nullptr, nullptr, nullptr, nullptr, nullptr, nullptr);
    if (fast(PH_WIN)) mega_launch(PH_WIN, PH_WIN + 1);
    else k_gemm_naive<FWin, false><<<dim3(D / 64, NTOK / 64), 256, 0, stream>>>(FWin{XN, w_in, U});
    if (fast(PH_SSM)) mega_launch(PH_SSM, PH_SSM + 1);
    else k_ssm_naive<<<NB_ * SG, 64, 0, stream>>>(U, tab, c_re, c_im, ssm_d, Z);
    if (fast(PH_WOUT)) mega_launch(PH_WOUT, PH_WOUT + 1);
    else k_gemm_naive<FWout, true><<<dim3(D / 64, NTOK / 64), 256, 0, stream>>>(FWout{Z, w_out, x, H});
    for (int layer = 0; layer < 2; ++layer) {
        unsigned* cnt = ctl + CW_COUNT + 32 * layer;
        if (layer == 1) {
            k_tok<false, true, false, false><<<NTOK / 4, 256, 0, stream>>>(nullptr, H, ln_mix + D, XN, nullptr, Y, slot, ctl + CW_COUNT, nullptr, nullptr, nullptr, nullptr, nullptr);
            if (fast(PH_QKV)) mega_launch(PH_QKV, PH_QKV + 1);
            else {
                k_gemm_naive<FQkv, false><<<dim3(3 * D / 64, NTOK / 64), 256, 0, stream>>>(FQkv{XN, w_qkv, Q});
                k_ksum_naive<<<NB_ * NH * NBLK, 128, 0, stream>>>(Kb, KSUM);
            }
            if (fast(PH_ATTN)) mega_launch(PH_ATTN, PH_ATTN + 1);
            else k_attn_naive<<<NB_ * NH * S / 4, 256, 0, stream>>>(Q, Kb, Vb, KSUM, O);
            if (fast(PH_WO)) mega_launch(PH_WO, PH_WO + 1);
            else k_gemm_naive<FWo, false><<<dim3(D / 64, NTOK / 64), 256, 0, stream>>>(FWo{O, w_o, H});
        }
        k_tok<false, false, true, false><<<NTOK / 4, 256, 0, stream>>>(nullptr, H, ln_ffn + layer * D, XN, nullptr, nullptr, nullptr, nullptr,
                                                                      w_group + (size_t)layer * D * NGRP, w_expert + (size_t)layer * D * NE, slot, cnt, rtok);
        const int ph1 = layer ? PH_MOE1_1 : PH_MOE1_0, ph2 = layer ? PH_MOE2_1 : PH_MOE2_0;
        if (fast(ph1)) mega_launch(ph1, ph1 + 1);
        else k_gemm_naive<FMoe1, true><<<dim3(FF / 64, MAXROWS / 64), 256, 0, stream>>>(FMoe1{XN, w1 + (size_t)layer * NE * D * FF, w3 + (size_t)layer * NE * D * FF, cnt, rtok, ACT});
        if (fast(ph2)) mega_launch(ph2, ph2 + 1);
        else k_gemm_naive<FMoe2, false><<<dim3(D / 64, MAXROWS / 64), 256, 0, stream>>>(FMoe2{ACT, w2 + (size_t)layer * NE * FF * D, cnt, Y});
    }
    k_tok<false, true, false, true><<<NTOK / 4, 256, 0, stream>>>(nullptr, H, ln_final, nullptr, out, Y, slot, ctl + CW_COUNT + 32, nullptr, nullptr, nullptr, nullptr, nullptr);
}
```
